# Optimizing an MI355X kernel written in HIP

```python
import jax, jax.numpy as jnp
from jax import lax
import numpy as np

D_MODEL = 2048
BATCH = 2
SEQ = 16384
DEPTH = 1

PLE_DIM = 256
MIX_WIDTH = D_MODEL
HGRN_WIDTH = MIX_WIDTH // 2
SGU_WIDTH = MIX_WIDTH - HGRN_WIDTH
HGRN_HEAD_DIM = 128
HGRN_HEADS = HGRN_WIDTH // HGRN_HEAD_DIM
HGRN_CHUNK = 64
SGU_CHUNK = 128
SGU_HEADS = 8
SGU_HEAD_DIM = SGU_WIDTH // SGU_HEADS
FFN_HIDDEN = -(-(8 * D_MODEL) // (3 * 256)) * 256
IN_COLS = 5 * HGRN_WIDTH + 2 * SGU_WIDTH
EPS = 1e-6

kernel_name = "hymba_hgrn2_gmlp_encoder_block"


def _rmsnorm(x, g):
    xf = x.astype(jnp.float32)
    y = xf * lax.rsqrt(jnp.mean(xf * xf, axis=-1, keepdims=True) + EPS)
    return (y * g.astype(jnp.float32)).astype(x.dtype)


def _layernorm(x, g, b):
    xf = x.astype(jnp.float32)
    mu = jnp.mean(xf, axis=-1, keepdims=True)
    xc = xf - mu
    y = xc * lax.rsqrt(jnp.mean(xc * xc, axis=-1, keepdims=True) + EPS)
    return (y * g.astype(jnp.float32) + b.astype(jnp.float32)).astype(x.dtype)


def _gla_chunkwise(q, k, v, log_f):
    B, H, L, K = q.shape
    V = v.shape[-1]
    n = L // HGRN_CHUNK

    def to_chunks(t):
        return t.reshape(B, H, n, HGRN_CHUNK, t.shape[-1]).transpose(2, 0, 1, 3, 4)

    mask = jnp.tril(jnp.ones((HGRN_CHUNK, HGRN_CHUNK), dtype=bool))[:, :, None]

    def step(S, inp):
        qi, ki, vi, gi = inp
        b = jnp.cumsum(gi, axis=2)
        diff = b[:, :, :, None, :] - b[:, :, None, :, :]
        decay = jnp.exp(jnp.where(mask, diff, -jnp.inf))
        scores = jnp.einsum('bhtk,bhsk,bhtsk->bhts', qi, ki, decay)
        o = (jnp.einsum('bhts,bhsv->bhtv', scores, vi)
             + jnp.einsum('bhtk,bhkv->bhtv', qi * jnp.exp(b), S))
        b_last = b[:, :, -1:, :]
        S = (jnp.exp(b_last[:, :, 0, :])[..., None] * S
             + jnp.einsum('bhsk,bhsv->bhkv', ki * jnp.exp(b_last - b), vi))
        return S, o

    S0 = jnp.zeros((B, H, K, V), jnp.float32)
    _, o = lax.scan(step, S0, (to_chunks(q), to_chunks(k), to_chunks(v), to_chunks(log_f)))
    return o.transpose(1, 2, 0, 3, 4).reshape(B, H, L, V)


def _hgrn2_bidir(q_raw, zf, zb, i_raw, g_raw, lb_f, lb_b, onorm_g):
    B, L, _ = q_raw.shape

    def heads(t):
        return t.astype(jnp.float32).reshape(B, L, HGRN_HEADS, HGRN_HEAD_DIM).transpose(0, 2, 1, 3)

    q = jax.nn.silu(heads(q_raw))
    v = heads(i_raw)

    def gates(z, lb):
        z = heads(z)
        lb = lb.astype(jnp.float32).reshape(HGRN_HEADS, 1, HGRN_HEAD_DIM)
        log_f = jnp.log(lb + (1.0 - lb) * jax.nn.sigmoid(z))
        k = (1.0 - lb) * jax.nn.sigmoid(-z)
        return k, log_f

    k_f, lf_f = gates(zf, lb_f)
    k_b, lf_b = gates(zb, lb_b)
    flip = lambda t: jnp.flip(t, axis=2)
    o_fwd = _gla_chunkwise(q, k_f, v, lf_f)
    o_bwd = flip(_gla_chunkwise(flip(q), flip(k_b), flip(v), flip(lf_b)))
    o = o_fwd + o_bwd
    o = o * lax.rsqrt(jnp.mean(o * o, axis=-1, keepdims=True) + EPS)
    o = o * onorm_g.astype(jnp.float32) * jax.nn.silu(heads(g_raw))
    return o.transpose(0, 2, 1, 3).reshape(B, L, HGRN_WIDTH).astype(q_raw.dtype)


def _sgu(u_raw, v_raw, ln_g, ln_b, w_s, b_s):
    B, L, _ = u_raw.shape
    u = jax.nn.gelu(u_raw, approximate=False)
    v = _layernorm(jax.nn.gelu(v_raw, approximate=False), ln_g, ln_b)
    vc = v.reshape(B, L // SGU_CHUNK, SGU_CHUNK, SGU_HEADS, SGU_HEAD_DIM)
    mixed = jnp.einsum('gts,bnsgd->bntgd', w_s, vc) + b_s.T[:, :, None]
    return u * mixed.reshape(B, L, SGU_WIDTH)


def setup_inputs(seed: int = 0) -> dict:
    key = jax.random.key(seed)
    ks = jax.random.split(key, 24)
    nrm = lambda k, shape, s: jax.random.normal(k, shape, jnp.float32) * s
    gain = lambda k, shape: 1.0 + nrm(k, shape, 0.02)
    return {
        "x": nrm(ks[0], (BATCH, SEQ, D_MODEL), 1.0),
        "p": nrm(ks[1], (DEPTH, BATCH, SEQ, PLE_DIM), 1.0),
        "norm_mix_g": gain(ks[2], (DEPTH, D_MODEL)),
        "w_in": nrm(ks[3], (DEPTH, D_MODEL, IN_COLS), D_MODEL ** -0.5),
        "lb_fwd_logits": nrm(ks[4], (DEPTH + 1, HGRN_WIDTH), 0.1),
        "lb_bwd_logits": nrm(ks[5], (DEPTH + 1, HGRN_WIDTH), 0.1),
        "hgrn_onorm_g": gain(ks[6], (DEPTH, HGRN_HEAD_DIM)),
        "sgu_ln_g": gain(ks[7], (DEPTH, SGU_WIDTH)),
        "sgu_ln_b": nrm(ks[8], (DEPTH, SGU_WIDTH), 0.02),
        "sgu_w": nrm(ks[9], (DEPTH, SGU_HEADS, SGU_CHUNK, SGU_CHUNK), SGU_CHUNK ** -0.5),
        "sgu_b": gain(ks[10], (DEPTH, SGU_HEADS, SGU_CHUNK)),
        "sgu_onorm_g": gain(ks[11], (DEPTH, SGU_WIDTH)),
        "w_out": nrm(ks[12], (DEPTH, MIX_WIDTH, D_MODEL), MIX_WIDTH ** -0.5),
        "norm_ffn_g": gain(ks[13], (DEPTH, D_MODEL)),
        "w_gate": nrm(ks[14], (DEPTH, D_MODEL, FFN_HIDDEN), D_MODEL ** -0.5),
        "w_up": nrm(ks[15], (DEPTH, D_MODEL, FFN_HIDDEN), D_MODEL ** -0.5),
        "w_down": nrm(ks[16], (DEPTH, FFN_HIDDEN, D_MODEL), FFN_HIDDEN ** -0.5),
        "norm_ple_g": gain(ks[17], (DEPTH, D_MODEL)),
        "w_ple_gate": nrm(ks[18], (DEPTH, D_MODEL, D_MODEL), D_MODEL ** -0.5),
        "w_ple_proj": nrm(ks[19], (DEPTH, PLE_DIM, D_MODEL), PLE_DIM ** -0.5),
        "final_norm_g": gain(ks[20], (D_MODEL,)),
    }


def reference(x, p, norm_mix_g, w_in, lb_fwd_logits, lb_bwd_logits, hgrn_onorm_g,
              sgu_ln_g, sgu_ln_b, sgu_w, sgu_b, sgu_onorm_g, w_out, norm_ffn_g,
              w_gate, w_up, w_down, norm_ple_g, w_ple_gate, w_ple_proj, final_norm_g):
    lb_f_all = jnp.cumsum(jax.nn.softmax(lb_fwd_logits.astype(jnp.float32), axis=0), axis=0)
    lb_b_all = jnp.cumsum(jax.nn.softmax(lb_bwd_logits.astype(jnp.float32), axis=0), axis=0)
    W, S = HGRN_WIDTH, SGU_WIDTH
    split_at = [W, 2 * W, 3 * W, 4 * W, 5 * W, 5 * W + S]
    h = x
    for layer in range(DEPTH):
        xn = _rmsnorm(h, norm_mix_g[layer])
        proj = xn @ w_in[layer]
        q_r, zf, zb, i_r, g_r, u_r, v_r = jnp.split(proj, split_at, axis=-1)
        a = _hgrn2_bidir(q_r, zf, zb, i_r, g_r, lb_f_all[layer], lb_b_all[layer],
                         hgrn_onorm_g[layer])
        s = _sgu(u_r, v_r, sgu_ln_g[layer], sgu_ln_b[layer], sgu_w[layer], sgu_b[layer])
        s = _rmsnorm(s, sgu_onorm_g[layer])
        h = h + jnp.concatenate([a, s], axis=-1) @ w_out[layer]
        hn = _rmsnorm(h, norm_ffn_g[layer])
        h = h + (jax.nn.silu(hn @ w_gate[layer]) * (hn @ w_up[layer])) @ w_down[layer]
        hp = _rmsnorm(h, norm_ple_g[layer])
        h = h + jax.nn.sigmoid(hp @ w_ple_gate[layer]) * (p[layer] @ w_ple_proj[layer])
    return _rmsnorm(h, final_norm_g)
```

```cpp
#include <hip/hip_runtime.h>
#include <hip/hip_cooperative_groups.h>
#include <cstdio>
#include <cstdint>
namespace cg = cooperative_groups;

#ifndef MK_N_LAUNCHES
#define MK_N_LAUNCHES 1
#endif

#define LAS __attribute__((address_space(3)))
typedef unsigned short bf16_t;
typedef short bf16x8 __attribute__((ext_vector_type(8)));
typedef float f32x4 __attribute__((ext_vector_type(4)));
typedef float f32x2 __attribute__((ext_vector_type(2)));
typedef unsigned u32x4 __attribute__((ext_vector_type(4)));
typedef unsigned u32x2 __attribute__((ext_vector_type(2)));

constexpr int BATCH = 2, SEQ = 16384, M = BATCH * SEQ, DM = 2048, INC = 7168, FF = 5632, PLE = 256;
constexpr int NHEAD = 8, NCHUNK = SEQ / 64;
constexpr float EPS = 1e-6f;
constexpr int C_Q = 0, C_ZF = 1024, C_ZB = 2048, C_I = 3072, C_G = 4096, C_U = 5120, C_V = 6144;
constexpr size_t PT_TILE = 8192, PT_SEG = 8 * PT_TILE, PT_CHUNK = 7 * PT_SEG;

constexpr size_t MiB = 1u << 20;
constexpr size_t WS_CTL = 0;
constexpr size_t WS_WIN = 1 * MiB, WS_WOUT = 29 * MiB, WS_WGU = 37 * MiB, WS_WDN = 81 * MiB, WS_WPG = 103 * MiB, WS_WPP = 111 * MiB, WS_SGUW = 112 * MiB;
constexpr size_t WS_PBF = 113 * MiB, WS_DEC = 129 * MiB, WS_PROJ = 133 * MiB, WS_CAT = 581 * MiB, WS_HB = 709 * MiB, WS_SEG = 965 * MiB, WS_CARRY = 981 * MiB, WS_DSEG = 997 * MiB, WS_END = 998 * MiB;
constexpr size_t WS_ACT = WS_PROJ, WS_PP = WS_CAT, WS_S = WS_HB;
constexpr int CT_LBF = 0, CT_LBB = 1024, CT_VSUM = 16384, CT_VSSQ = CT_VSUM + M, CT_SSQ1 = CT_VSSQ + M, CT_SSQ2 = CT_SSQ1 + M, CT_SSQ3 = CT_SSQ2 + M;
static_assert((size_t)(CT_SSQ3 + M) * 4 <= 1 * MiB, "ctl");

constexpr int LDS_BYTES = 147456;
constexpr size_t WS_BAR = 768 * 1024;
constexpr int LDS_BARST = 147200;

typedef __bf16 bf16v2 __attribute__((ext_vector_type(2)));
__device__ __forceinline__ unsigned cvt_pk_bf16(float lo, float hi) { const f32x2 v = {lo, hi}; const bf16v2 r = __builtin_convertvector(v, bf16v2); return __builtin_bit_cast(unsigned, r); }
__device__ __forceinline__ float bf2f(unsigned short h) { return __uint_as_float((unsigned)h << 16); }
__device__ __forceinline__ float bflo(unsigned w) { return __uint_as_float(w << 16); }
__device__ __forceinline__ float bfhi(unsigned w) { return __uint_as_float(w & 0xffff0000u); }
__device__ __forceinline__ float h2f(unsigned short h) { return (float)__builtin_bit_cast(_Float16, h); }
__device__ __forceinline__ unsigned short f2h(float f) { return __builtin_bit_cast(unsigned short, (_Float16)f); }
__device__ __forceinline__ float fsigmoid(float x) { return __builtin_amdgcn_rcpf(1.0f + __expf(-x)); }
__device__ __forceinline__ float fsilu(float x) { return x * fsigmoid(x); }
__device__ __forceinline__ float wave_sum(float v) {
#pragma unroll
    for (int o = 1; o < 64; o <<= 1) v += __shfl_xor(v, o);
    return v;
}
__device__ __forceinline__ void atomic_addf(float* p, float v) { __hip_atomic_fetch_add(p, v, __ATOMIC_RELAXED, __HIP_MEMORY_SCOPE_AGENT); }
__device__ __forceinline__ float gelu1(float v) {
    const float av = __builtin_fabsf(v), t = __builtin_amdgcn_rcpf(av * 0.2316418882f + 1.0f);
    float q = t * 0.5307027145f + (-0.7265760135f); q = q * t + 0.7107068705f; q = q * t + (-0.142248368f); q = q * t + 0.127414796f; q = q * t;
    const float e = __builtin_amdgcn_exp2f((v * v) * (-0.72134752044f));
    const float m = v * (q * e);
    return v < 0.f ? m : v - m;
}

__device__ __forceinline__ int fresh_tid();
typedef _Float16 f16v2 __attribute__((ext_vector_type(2)));
__device__ __forceinline__ f32x2 exp2_pk(f32x2 v) { f32x2 r; r.x = __builtin_amdgcn_exp2f(v.x); r.y = __builtin_amdgcn_exp2f(v.y); return r; }
__device__ __forceinline__ f32x2 rcp_pk(f32x2 v) { f32x2 r; r.x = __builtin_amdgcn_rcpf(v.x); r.y = __builtin_amdgcn_rcpf(v.y); return r; }
__device__ __forceinline__ f32x2 log2_pk(f32x2 v) { f32x2 r; r.x = __builtin_amdgcn_logf(v.x); r.y = __builtin_amdgcn_logf(v.y); return r; }
__device__ __forceinline__ f32x2 sigmoid_pk(f32x2 x) { return rcp_pk(exp2_pk(x * (-1.4426950408889634f)) + 1.0f); }
__device__ __forceinline__ f32x2 silu_pk(f32x2 x) { return x * sigmoid_pk(x); }
__device__ __forceinline__ f32x2 gelu_pk(f32x2 v) {
    const f32x2 av = __builtin_elementwise_abs(v), d = av * 0.2316418882f + 1.0f;
    const f32x2 t = rcp_pk(d);
    f32x2 q = t * 0.5307027145f + (-0.7265760135f); q = q * t + 0.7107068705f; q = q * t + (-0.142248368f); q = q * t + 0.127414796f; q = q * t;
    const f32x2 e = exp2_pk((v * v) * (-0.72134752044f));
    const f32x2 m = v * (q * e), r = v - m;
    f32x2 o; o.x = v.x < 0.f ? m.x : r.x; o.y = v.y < 0.f ? m.y : r.y; return o;
}
__device__ __forceinline__ unsigned cvt_pk_bf16v(f32x2 v) { const bf16v2 r = __builtin_convertvector(v, bf16v2); return __builtin_bit_cast(unsigned, r); }
__device__ __forceinline__ unsigned cvt_pk_f16v(f32x2 v) { const f16v2 r = __builtin_convertvector(v, f16v2); return __builtin_bit_cast(unsigned, r); }
namespace pg8 {
constexpr int BM = 256, BK = 64, HALF = 128, HTB = HALF * BK * 2, STAGE_BYTES = 8 * HTB, NXCD = 8, WGM = 8;
__host__ __device__ __forceinline__ int lds_byte(int r, int c) { const int st = (r >> 4) * 2 + (c >> 5), rr = r & 15, cc = c & 31, ob = rr * 64 + cc * 2; return st * 1024 + (ob ^ (((ob >> 9) & 1) << 5)); }
__host__ __device__ __forceinline__ void stage_rc(int b, int& R, int& C) { const int st = b / 1024, sb = b % 1024, swz = sb ^ (((sb >> 9) & 1) << 5); R = (st >> 1) * 16 + swz / 64; C = (st & 1) * 32 + (swz % 64) / 2; }
__host__ __device__ __forceinline__ int perm32(int rho) { const int n = rho >> 4, i = rho & 15; return 8 * (i >> 2) + 4 * n + (i & 3); }

struct Unit { int pm, pn; };
struct Gemm { const bf16_t* A; const bf16_t* Bt; int M, N, K; };

struct StaticOrder {
    int nM, nN, nwg, G, c;
    __host__ __device__ __forceinline__ void init(int M_, int N_, int G_, int c_) { nM = M_ / BM; nN = N_ / BM; nwg = nM * nN; G = G_; c = c_; }
    __host__ __device__ __forceinline__ bool next(int i, Unit& u) const {
        const long L = (long)i * G + c; if (L >= nwg) return false;
        int wgid = (int)L; { const int q = nwg / NXCD, r = nwg % NXCD, xcd = wgid % NXCD, off = wgid / NXCD; wgid = (xcd < r ? xcd * (q + 1) : r * (q + 1) + (xcd - r) * q) + off; }
        const int nig = WGM * nN, gid = wgid / nig, fm = gid * WGM, gsz = (nM - fm) < WGM ? (nM - fm) : WGM;
        u.pm = fm + ((wgid % nig) % gsz); u.pn = (wgid % nig) / gsz; return true;
    }
};

typedef f32x4 Acc[2][2][4][2];

template <class Epi, class Sched, bool ALIGN_EPI = true>
__device__ __forceinline__ void gemm_phase(LAS unsigned char* lds, const Gemm g, const Sched& S, const Epi& E) {
    const int tid = fresh_tid(), wid = __builtin_amdgcn_readfirstlane(tid >> 6), lane = tid & 63, wr = wid >> 2, wc = wid & 3, fr = lane & 15, fq = lane >> 4;
    const int K = g.K, nt = K / BK;
    unsigned voffA[2], voffB[2];
#pragma unroll
    for (int i = 0; i < 2; ++i) { int R, C; stage_rc(tid * 16 + i * 8192, R, C); const int Rb = Epi::PERM ? ((R & ~31) + perm32(R & 31)) : R;
        voffA[i] = (unsigned)(R * K + C) * 2u; voffB[i] = (unsigned)(Rb * K + C) * 2u; }
    const size_t kstep = (size_t)(BK * 2);
    const size_t hstep = (size_t)HALF * K * 2;
    const size_t tstep = 2 * hstep;
    const unsigned ldsw = (unsigned)wid * 1024u;
    const int aoff = lds_byte(wr * 64 + fr, fq * 8), boff = lds_byte(wc * 32 + fr, fq * 8);
#define PG8_SA(b, h) (((b) * 2 + (h)) * HTB)
#define PG8_SB(b, h) ((4 + (b) * 2 + (h)) * HTB)
#define PG8_STAGE(bufoff, gbase, voff) do { _Pragma("unroll") for (int _i = 0; _i < 2; ++_i) \
        __builtin_amdgcn_global_load_lds((const unsigned*)((const char*)(gbase) + (voff)[_i]), (LAS unsigned*)(lds + (bufoff) + ldsw + _i * 8192), 16, 0, 0); } while (0)
#define PG8_LDA(dst, b, h) do { _Pragma("unroll") for (int m = 0; m < 4; ++m) _Pragma("unroll") for (int k = 0; k < 2; ++k) dst[m][k] = *(const LAS bf16x8*)(lds + PG8_SA(b, h) + aoff + m * 2048 + k * 1024); } while (0)
#define PG8_LDB(dst, b, h) do { _Pragma("unroll") for (int n = 0; n < 2; ++n) _Pragma("unroll") for (int k = 0; k < 2; ++k) dst[n][k] = *(const LAS bf16x8*)(lds + PG8_SB(b, h) + boff + n * 2048 + k * 1024); } while (0)
#define PG8_MMA(ai, bj, At, Bt) do { __builtin_amdgcn_s_setprio(1); _Pragma("unroll") for (int m = 0; m < 4; ++m) _Pragma("unroll") for (int n = 0; n < 2; ++n) _Pragma("unroll") for (int k = 0; k < 2; ++k) \
        acc[ai][bj][m][n] = __builtin_amdgcn_mfma_f32_16x16x32_bf16(Bt[n][k], At[m][k], acc[ai][bj][m][n], 0, 0, 0); __builtin_amdgcn_s_setprio(0); } while (0)
#define PG8_WAIT_V(n) asm volatile("s_waitcnt vmcnt(" #n ")" ::: "memory")
#define PG8_WAIT_L(n) asm volatile("s_waitcnt lgkmcnt(" #n ")" ::: "memory")
#define PG8_BAR __builtin_amdgcn_s_barrier()
#define PG8_SCHED __builtin_amdgcn_sched_barrier(0)
    Unit cur, nxt; int ui = 0;
    if (!S.next(0, cur)) return;
    Acc acc;
#pragma unroll
    for (int a = 0; a < 2; ++a)
#pragma unroll
        for (int b = 0; b < 2; ++b)
#pragma unroll
            for (int m = 0; m < 4; ++m)
#pragma unroll
                for (int n = 0; n < 2; ++n) acc[a][b][m][n] = (f32x4){0.f, 0.f, 0.f, 0.f};
    bf16x8 At[4][2], B0[2][2], B1[2][2];
    const char* cA = (const char*)g.A + (size_t)cur.pm * tstep; const char* cB = (const char*)g.Bt + (size_t)cur.pn * tstep;
    PG8_STAGE(PG8_SB(0, 0), cB, voffB); PG8_STAGE(PG8_SB(0, 1), cB + hstep, voffB); PG8_STAGE(PG8_SA(0, 0), cA, voffA); PG8_STAGE(PG8_SA(0, 1), cA + hstep, voffA);
    if (wr == 1) PG8_BAR;
    PG8_WAIT_V(2); PG8_BAR;
    PG8_STAGE(PG8_SB(1, 0), cB + kstep, voffB); PG8_STAGE(PG8_SA(1, 0), cA + kstep, voffA); PG8_STAGE(PG8_SB(1, 1), cB + hstep + kstep, voffB);
    PG8_WAIT_V(6); PG8_BAR;
    for (;;) {
        const bool has_next = S.next(ui + 1, nxt);
        const char* nA = has_next ? (const char*)g.A + (size_t)nxt.pm * tstep : cA; const char* nB = has_next ? (const char*)g.Bt + (size_t)nxt.pn * tstep : cB;
        for (int t = 0; t < nt; t += 2) {
            const bool last = (t == nt - 2);
            const char* a1 = cA + (size_t)(t + 1) * kstep;
            const char* a2 = last ? nA : cA + (size_t)(t + 2) * kstep; const char* b2 = last ? nB : cB + (size_t)(t + 2) * kstep;
            const char* a3 = a2 + kstep; const char* b3 = b2 + kstep;
            PG8_LDB(B0, 0, 0); PG8_LDB(B1, 0, 1); PG8_SCHED; PG8_LDA(At, 0, 0); PG8_STAGE(PG8_SA(1, 1), a1 + hstep, voffA);
            PG8_WAIT_V(8); PG8_WAIT_L(0); PG8_BAR; PG8_MMA(0, 0, At, B0); PG8_MMA(0, 1, At, B1); PG8_BAR; PG8_SCHED;
            PG8_LDA(At, 0, 1); PG8_STAGE(PG8_SB(0, 0), b2, voffB); PG8_STAGE(PG8_SB(0, 1), b2 + hstep, voffB); PG8_STAGE(PG8_SA(0, 0), a2, voffA);
            PG8_WAIT_V(8); PG8_WAIT_L(0); PG8_BAR; PG8_MMA(1, 0, At, B0); PG8_MMA(1, 1, At, B1); PG8_BAR; PG8_SCHED;
            PG8_LDB(B0, 1, 0); PG8_LDB(B1, 1, 1); PG8_SCHED; PG8_LDA(At, 1, 0); PG8_STAGE(PG8_SA(0, 1), a2 + hstep, voffA);
            PG8_WAIT_V(8); PG8_WAIT_L(0); PG8_BAR; PG8_MMA(0, 0, At, B0); PG8_MMA(0, 1, At, B1); PG8_BAR; PG8_SCHED;
            PG8_LDA(At, 1, 1); PG8_STAGE(PG8_SB(1, 0), b3, voffB); PG8_STAGE(PG8_SB(1, 1), b3 + hstep, voffB); PG8_STAGE(PG8_SA(1, 0), a3, voffA);
            PG8_WAIT_V(8); PG8_WAIT_L(0); PG8_BAR; PG8_MMA(1, 0, At, B0); PG8_MMA(1, 1, At, B1); PG8_BAR; PG8_SCHED;
        }
        if constexpr (ALIGN_EPI) { if (wr == 0) PG8_BAR; }
        E(acc, cur, wr, wc, fr, fq);
        if (!has_next) break;
#pragma unroll
        for (int a = 0; a < 2; ++a)
#pragma unroll
            for (int b = 0; b < 2; ++b)
#pragma unroll
                for (int m = 0; m < 4; ++m)
#pragma unroll
                    for (int n = 0; n < 2; ++n) acc[a][b][m][n] = (f32x4){0.f, 0.f, 0.f, 0.f};
        cur = nxt; cA = nA; cB = nB; ++ui;
        if constexpr (ALIGN_EPI) { if (wr == 1) PG8_BAR; }
    }
    PG8_WAIT_V(0);
    if constexpr (!ALIGN_EPI) { if (wr == 0) PG8_BAR; }
    PG8_BAR;
#undef PG8_SA
#undef PG8_SB
#undef PG8_STAGE
#undef PG8_LDA
#undef PG8_LDB
#undef PG8_MMA
#undef PG8_WAIT_V
#undef PG8_WAIT_L
#undef PG8_BAR
#undef PG8_SCHED
}
}
using pg8::Acc; using pg8::Unit;

#define EPI_FENCE() asm volatile("" ::: "memory")

struct EpiIn {
    static constexpr bool PERM = true;
    bf16_t* O; const float* lbf; const float* lbb; float* vsum; float* vssq; int seg_base;
    template <int SEG> __device__ __forceinline__ void body(const Acc& acc, const Unit& u, int wr, int wc, int fr, int fq) const {
        const int row0 = u.pm * 256 + wr * 64 + fr, col0 = u.pn * 256 + wc * 32 + 8 * fq;
        f32x2 lb[2][4], oml[2][4];
        if (SEG == 1 || SEG == 2) {
            const float* lp = (SEG == 1 ? lbf : lbb) + (col0 - SEG * 1024);
#pragma unroll
            for (int bj = 0; bj < 2; ++bj)
#pragma unroll
                for (int e = 0; e < 4; ++e) { lb[bj][e] = (f32x2){lp[bj * 128 + 2 * e], lp[bj * 128 + 2 * e + 1]}; oml[bj][e] = 1.0f - lb[bj][e]; }
        }
#pragma unroll
        for (int ai = 0; ai < 2; ++ai)
#pragma unroll
            for (int m = 0; m < 4; ++m) {
                const int row = row0 + ai * 128 + m * 16;
                bf16_t* rowp = O + (size_t)(u.pm * 4 + ai * 2 + wr) * PT_CHUNK + (size_t)SEG * PT_SEG + (size_t)((u.pn & 3) * 2) * PT_TILE + (m * 16 + fr) * 128 + wc * 32 + 8 * fq;
                f32x2 s1 = {0.f, 0.f}, s2 = {0.f, 0.f};
#pragma unroll
                for (int bj = 0; bj < 2; ++bj) {
                    f32x2 v[4];
                    v[0] = (f32x2){acc[ai][bj][m][0][0], acc[ai][bj][m][0][1]}; v[1] = (f32x2){acc[ai][bj][m][0][2], acc[ai][bj][m][0][3]};
                    v[2] = (f32x2){acc[ai][bj][m][1][0], acc[ai][bj][m][1][1]}; v[3] = (f32x2){acc[ai][bj][m][1][2], acc[ai][bj][m][1][3]};
                    u32x4 w;
                    if (SEG == 1 || SEG == 2) {
                        unsigned hw[4];
#pragma unroll
                        for (int e = 0; e < 4; ++e) { const f32x2 f = lb[bj][e] + oml[bj][e] * sigmoid_pk(v[e]); hw[e] = cvt_pk_f16v(log2_pk(f) * 0.6931471805599453f); }
                        w.x = hw[0]; w.y = hw[1]; w.z = hw[2]; w.w = hw[3];
                    } else {
#pragma unroll
                        for (int e = 0; e < 4; ++e) {
                            if (SEG == 0 || SEG == 4) v[e] = silu_pk(v[e]);
                            if (SEG == 5 || SEG == 6) v[e] = gelu_pk(v[e]);
                            if (SEG == 6) { s1 += v[e]; s2 += v[e] * v[e]; }
                        }
                        w.x = cvt_pk_bf16v(v[0]); w.y = cvt_pk_bf16v(v[1]); w.z = cvt_pk_bf16v(v[2]); w.w = cvt_pk_bf16v(v[3]);
                    }
                    *(u32x4*)(rowp + bj * PT_TILE) = w;
                    EPI_FENCE();
                }
                if (SEG == 6) {
                    float a1 = s1.x + s1.y, a2 = s2.x + s2.y;
                    a1 += __shfl_xor(a1, 16); a1 += __shfl_xor(a1, 32); a2 += __shfl_xor(a2, 16); a2 += __shfl_xor(a2, 32);
                    if (fq == 0) { atomic_addf(vsum + row, a1); atomic_addf(vssq + row, a2); }
                }
            }
    }
    __device__ __forceinline__ void operator()(const Acc& acc, const Unit& u, int wr, int wc, int fr, int fq) const {
        switch ((u.pn >> 2) + seg_base) {
            case 0: body<0>(acc, u, wr, wc, fr, fq); break;
            case 1: body<1>(acc, u, wr, wc, fr, fq); break;
            case 2: body<2>(acc, u, wr, wc, fr, fq); break;
            case 3: body<3>(acc, u, wr, wc, fr, fq); break;
            case 4: body<4>(acc, u, wr, wc, fr, fq); break;
            case 5: body<5>(acc, u, wr, wc, fr, fq); break;
            default: body<6>(acc, u, wr, wc, fr, fq); break;
        }
    }
};
struct EpiInT {
    static constexpr bool PERM = true;
    bf16_t* O; const float* lbf; const float* lbb;
    template <int SEG> __device__ __forceinline__ void body(const Acc& acc, const Unit& u, int wr, int wc, int fr, int fq) const {
        const int chunk0 = u.pn * 4 + (wc >> 1), s0 = 32 * (wc & 1) + 8 * fq;
        float lbv[2][4];
        if (SEG == 1 || SEG == 2) {
            const float* lp = (SEG == 1 ? lbf : lbb) + (u.pm & 3) * 256 + 64 * wr + fr;
#pragma unroll
            for (int ai = 0; ai < 2; ++ai)
#pragma unroll
                for (int m = 0; m < 4; ++m) lbv[ai][m] = lp[ai * 128 + 16 * m];
        }
#pragma unroll
        for (int ai = 0; ai < 2; ++ai)
#pragma unroll
            for (int m = 0; m < 4; ++m) {
                const int hh = (u.pm & 3) * 2 + ai, kk = 64 * wr + 16 * m + fr;
                bf16_t* tp = O + (size_t)SEG * PT_SEG + (size_t)hh * PT_TILE + kk * 64 + s0;
                const float l = (SEG == 1 || SEG == 2) ? lbv[ai][m] : 0.f, oml = 1.0f - l;
#pragma unroll
                for (int bj = 0; bj < 2; ++bj) {
                    f32x2 v[4];
                    v[0] = (f32x2){acc[ai][bj][m][0][0], acc[ai][bj][m][0][1]}; v[1] = (f32x2){acc[ai][bj][m][0][2], acc[ai][bj][m][0][3]};
                    v[2] = (f32x2){acc[ai][bj][m][1][0], acc[ai][bj][m][1][1]}; v[3] = (f32x2){acc[ai][bj][m][1][2], acc[ai][bj][m][1][3]};
                    u32x4 w;
                    if (SEG == 1 || SEG == 2) {
                        unsigned hw[4];
#pragma unroll
                        for (int e = 0; e < 4; ++e) { const f32x2 f = sigmoid_pk(v[e]) * oml + l; hw[e] = cvt_pk_f16v(log2_pk(f) * 0.6931471805599453f); }
                        w.x = hw[0]; w.y = hw[1]; w.z = hw[2]; w.w = hw[3];
                    } else {
                        if (SEG == 0) {
#pragma unroll
                            for (int e = 0; e < 4; ++e) v[e] = silu_pk(v[e]);
                        }
                        w.x = cvt_pk_bf16v(v[0]); w.y = cvt_pk_bf16v(v[1]); w.z = cvt_pk_bf16v(v[2]); w.w = cvt_pk_bf16v(v[3]);
                    }
                    *(u32x4*)(tp + (size_t)(chunk0 + 2 * bj) * PT_CHUNK) = w;
                    EPI_FENCE();
                }
            }
    }
    __device__ __forceinline__ void operator()(const Acc& acc, const Unit& u, int wr, int wc, int fr, int fq) const {
        switch (u.pm >> 2) {
            case 0: body<0>(acc, u, wr, wc, fr, fq); break;
            case 1: body<1>(acc, u, wr, wc, fr, fq); break;
            case 2: body<2>(acc, u, wr, wc, fr, fq); break;
            default: body<3>(acc, u, wr, wc, fr, fq); break;
        }
    }
};
template <bool BB> struct EpiRes {
    static constexpr bool PERM = true;
    const float* base; bf16_t* hb; float* ssq;
    __device__ __forceinline__ void operator()(const Acc& acc, const Unit& u, int wr, int wc, int fr, int fq) const {
        const int row0 = u.pm * 256 + wr * 64 + fr, col0 = u.pn * 256 + wc * 32 + 8 * fq;
#pragma unroll
        for (int ai = 0; ai < 2; ++ai) {
            f32x4 bv[4][2][2]; u32x4 bw[4][2];
#pragma unroll
            for (int m = 0; m < 4; ++m) { const size_t off = (size_t)(row0 + ai * 128 + m * 16) * DM + col0;
#pragma unroll
                for (int bj = 0; bj < 2; ++bj) {
                    if (BB) bw[m][bj] = *(const u32x4*)(hb + off + bj * 128);
                    else { bv[m][bj][0] = *(const f32x4*)(base + off + bj * 128); bv[m][bj][1] = *(const f32x4*)(base + off + bj * 128 + 4); } } }
            EPI_FENCE();
#pragma unroll
            for (int m = 0; m < 4; ++m) {
                const int row = row0 + ai * 128 + m * 16; const size_t off = (size_t)row * DM + col0;
                float s2 = 0.f;
#pragma unroll
                for (int bj = 0; bj < 2; ++bj) {
                    f32x4 b0, b1;
                    if (BB) { const u32x4 q = bw[m][bj]; b0 = (f32x4){bflo(q.x), bfhi(q.x), bflo(q.y), bfhi(q.y)}; b1 = (f32x4){bflo(q.z), bfhi(q.z), bflo(q.w), bfhi(q.w)}; }
                    else { b0 = bv[m][bj][0]; b1 = bv[m][bj][1]; }
                    const f32x4 h0 = b0 + acc[ai][bj][m][0], h1 = b1 + acc[ai][bj][m][1];
                    u32x4 w; w.x = cvt_pk_bf16(h0[0], h0[1]); w.y = cvt_pk_bf16(h0[2], h0[3]); w.z = cvt_pk_bf16(h1[0], h1[1]); w.w = cvt_pk_bf16(h1[2], h1[3]);
                    *(u32x4*)(hb + off + bj * 128) = w;
                    s2 += (h0[0] * h0[0] + h0[1] * h0[1]) + (h0[2] * h0[2] + h0[3] * h0[3]) + (h1[0] * h1[0] + h1[1] * h1[1]) + (h1[2] * h1[2] + h1[3] * h1[3]);
                }
                s2 += __shfl_xor(s2, 16); s2 += __shfl_xor(s2, 32);
                if (fq == 0) atomic_addf(ssq + row, s2);
            }
            EPI_FENCE();
        }
    }
};
struct EpiGU {
    static constexpr bool PERM = true;
    bf16_t* act; const float* ssq;
    __device__ __forceinline__ void operator()(const Acc& acc, const Unit& u, int wr, int wc, int fr, int fq) const {
        const int row0 = u.pm * 256 + wr * 64 + fr, col0 = u.pn * 128 + wc * 32 + 8 * fq;
        float rsv[2][4];
#pragma unroll
        for (int ai = 0; ai < 2; ++ai)
#pragma unroll
            for (int m = 0; m < 4; ++m) rsv[ai][m] = ssq[row0 + ai * 128 + m * 16];
        EPI_FENCE();
#pragma unroll
        for (int ai = 0; ai < 2; ++ai)
#pragma unroll
            for (int m = 0; m < 4; ++m) {
                const int row = row0 + ai * 128 + m * 16;
                const float rs = __builtin_amdgcn_rsqf(rsv[ai][m] * (1.0f / DM) + EPS);
                const float nrs = rs * (-1.4426950408889634f), rs2 = rs * rs;
                unsigned ow[4];
#pragma unroll
                for (int e = 0; e < 4; ++e) {
                    const f32x2 g2 = {acc[ai][0][m][e >> 1][2 * (e & 1)], acc[ai][0][m][e >> 1][2 * (e & 1) + 1]}, u2 = {acc[ai][1][m][e >> 1][2 * (e & 1)], acc[ai][1][m][e >> 1][2 * (e & 1) + 1]};
                    ow[e] = cvt_pk_bf16v((g2 * u2) * (rcp_pk(exp2_pk(g2 * nrs) + 1.0f) * rs2));
                }
                u32x4 w; w.x = ow[0]; w.y = ow[1]; w.z = ow[2]; w.w = ow[3];
                *(u32x4*)(act + (size_t)row * FF + col0) = w;
                EPI_FENCE();
            }
    }
};
struct EpiPP {
    static constexpr bool PERM = true;
    bf16_t* O;
    __device__ __forceinline__ void operator()(const Acc& acc, const Unit& u, int wr, int wc, int fr, int fq) const {
        const int row0 = u.pm * 256 + wr * 64 + fr, col0 = u.pn * 256 + wc * 32 + 8 * fq;
#pragma unroll
        for (int ai = 0; ai < 2; ++ai)
#pragma unroll
            for (int m = 0; m < 4; ++m) {
                bf16_t* rowp = O + (size_t)(row0 + ai * 128 + m * 16) * DM + col0;
#pragma unroll
                for (int bj = 0; bj < 2; ++bj) {
                    const f32x4 v0 = acc[ai][bj][m][0], v1 = acc[ai][bj][m][1];
                    u32x4 w; w.x = cvt_pk_bf16(v0[0], v0[1]); w.y = cvt_pk_bf16(v0[2], v0[3]); w.z = cvt_pk_bf16(v1[0], v1[1]); w.w = cvt_pk_bf16(v1[2], v1[3]);
                    *(u32x4*)(rowp + bj * 128) = w;
                    EPI_FENCE();
                }
            }
    }
};
struct EpiPle {
    static constexpr bool PERM = true;
    const bf16_t* hb; bf16_t* h3b; const bf16_t* pp; const float* ssq_in; float* ssq_out;
    __device__ __forceinline__ void operator()(const Acc& acc, const Unit& u, int wr, int wc, int fr, int fq) const {
        const int row0 = u.pm * 256 + wr * 64 + fr, col0 = u.pn * 256 + wc * 32 + 8 * fq;
#pragma unroll
        for (int ai = 0; ai < 2; ++ai) {
            u32x4 bw[4][2], pw[4][2]; float rsv[4];
#pragma unroll
            for (int m = 0; m < 4; ++m) { const int row = row0 + ai * 128 + m * 16; const size_t off = (size_t)row * DM + col0;
                rsv[m] = ssq_in[row];
#pragma unroll
                for (int bj = 0; bj < 2; ++bj) { bw[m][bj] = *(const u32x4*)(hb + off + bj * 128); pw[m][bj] = *(const u32x4*)(pp + off + bj * 128); } }
            EPI_FENCE();
#pragma unroll
            for (int m = 0; m < 4; ++m) {
                const int row = row0 + ai * 128 + m * 16; const size_t off = (size_t)row * DM + col0;
                const float rs = __builtin_amdgcn_rsqf(rsv[m] * (1.0f / DM) + EPS);
                float s2 = 0.f;
#pragma unroll
                for (int bj = 0; bj < 2; ++bj) {
                    const u32x4 q = bw[m][bj], pq = pw[m][bj];
                    f32x4 h0, h1;
                    h0[0] = bflo(q.x) + fsigmoid(acc[ai][bj][m][0][0] * rs) * bflo(pq.x); h0[1] = bfhi(q.x) + fsigmoid(acc[ai][bj][m][0][1] * rs) * bfhi(pq.x);
                    h0[2] = bflo(q.y) + fsigmoid(acc[ai][bj][m][0][2] * rs) * bflo(pq.y); h0[3] = bfhi(q.y) + fsigmoid(acc[ai][bj][m][0][3] * rs) * bfhi(pq.y);
                    h1[0] = bflo(q.z) + fsigmoid(acc[ai][bj][m][1][0] * rs) * bflo(pq.z); h1[1] = bfhi(q.z) + fsigmoid(acc[ai][bj][m][1][1] * rs) * bfhi(pq.z);
                    h1[2] = bflo(q.w) + fsigmoid(acc[ai][bj][m][1][2] * rs) * bflo(pq.w); h1[3] = bfhi(q.w) + fsigmoid(acc[ai][bj][m][1][3] * rs) * bfhi(pq.w);
                    u32x4 w; w.x = cvt_pk_bf16(h0[0], h0[1]); w.y = cvt_pk_bf16(h0[2], h0[3]); w.z = cvt_pk_bf16(h1[0], h1[1]); w.w = cvt_pk_bf16(h1[2], h1[3]);
                    *(u32x4*)(h3b + off + bj * 128) = w;
                    s2 += (h0[0] * h0[0] + h0[1] * h0[1]) + (h0[2] * h0[2] + h0[3] * h0[3]) + (h1[0] * h1[0] + h1[1] * h1[1]) + (h1[2] * h1[2] + h1[3] * h1[3]);
                }
                s2 += __shfl_xor(s2, 16); s2 += __shfl_xor(s2, 32);
                if (fq == 0) atomic_addf(ssq_out + row, s2);
            }
            EPI_FENCE();
        }
    }
};

struct Args { const float* in[21]; float* out; unsigned char* ws; int ph_lo, ph_hi; };
struct Frame {
    LAS unsigned char* lds; int G, bid;
    const float* const* in; float* out; unsigned char* ws;
};
__device__ __forceinline__ int fresh_tid() { int t = threadIdx.x; asm volatile("" : "+v"(t)); return t; }
#define PHASE_IDS() const int tid = fresh_tid(), lane = tid & 63, wave = __builtin_amdgcn_readfirstlane(tid >> 6); (void)lane; (void)wave
#define F_IN(i) (F.in[i])
#define F_x F_IN(0)
#define F_p F_IN(1)
#define F_norm_mix_g F_IN(2)
#define F_w_in F_IN(3)
#define F_lbfl F_IN(4)
#define F_lbbl F_IN(5)
#define F_onorm_g F_IN(6)
#define F_ln_g F_IN(7)
#define F_ln_b F_IN(8)
#define F_sgu_w F_IN(9)
#define F_sgu_b F_IN(10)
#define F_sgu_onorm F_IN(11)
#define F_w_out F_IN(12)
#define F_norm_ffn_g F_IN(13)
#define F_w_gate F_IN(14)
#define F_w_up F_IN(15)
#define F_w_down F_IN(16)
#define F_norm_ple_g F_IN(17)
#define F_w_pg F_IN(18)
#define F_w_pp F_IN(19)
#define F_final_g F_IN(20)
#define F_ctl ((float*)(F.ws + WS_CTL))
#define F_WIN ((bf16_t*)(F.ws + WS_WIN))
#define F_WOUT ((bf16_t*)(F.ws + WS_WOUT))
#define F_WGU ((bf16_t*)(F.ws + WS_WGU))
#define F_WDN ((bf16_t*)(F.ws + WS_WDN))
#define F_WPG ((bf16_t*)(F.ws + WS_WPG))
#define F_WPP ((bf16_t*)(F.ws + WS_WPP))
#define F_SGUW ((bf16_t*)(F.ws + WS_SGUW))
#define F_PBF ((bf16_t*)(F.ws + WS_PBF))
#define F_PROJ ((bf16_t*)(F.ws + WS_PROJ))
#define F_CAT ((bf16_t*)(F.ws + WS_CAT))
#define F_HB ((bf16_t*)(F.ws + WS_HB))
#define F_ACT ((bf16_t*)(F.ws + WS_ACT))
#define F_PP ((bf16_t*)(F.ws + WS_PP))
#define F_S ((bf16_t*)(F.ws + WS_S))
#define F_H3B ((bf16_t*)(F.ws + WS_ACT))
#define F_DEC ((float*)(F.ws + WS_DEC))
#define F_SEG ((bf16_t*)(F.ws + WS_SEG))
#define F_CARRY ((bf16_t*)(F.ws + WS_CARRY))
#define F_DSEG ((float*)(F.ws + WS_DSEG))
#define LDS_WAIT() asm volatile("s_waitcnt lgkmcnt(0)" ::: "memory")
#define LBAR() do { asm volatile("s_waitcnt lgkmcnt(0)" ::: "memory"); __builtin_amdgcn_s_barrier(); asm volatile("" ::: "memory"); } while (0)

constexpr int TRP = 136;
__device__ __forceinline__ void p0_transpose_item(const float* W, int K, int N, bf16_t* WT, const float* ksc, int mode, LAS unsigned char* scr, int item, int lane) {
    const int nblk = N / 64, kb = item / nblk, nb = item % nblk, k0 = 64 * kb, n0 = 64 * nb;
    const int lr = lane >> 4, lc = lane & 15;
#pragma unroll 8
    for (int i = 0; i < 16; ++i) { const int kk = 4 * i + lr; f32x4 v = *(const f32x4*)(W + (size_t)(k0 + kk) * N + n0 + 4 * lc); if (ksc) v = v * ksc[k0 + kk];
        u32x2 w; w.x = cvt_pk_bf16(v[0], v[1]); w.y = cvt_pk_bf16(v[2], v[3]); *(LAS u32x2*)(scr + kk * TRP + lc * 8) = w; }
    LDS_WAIT(); asm volatile("" ::: "memory");
    const int d0 = mode == 0 ? n0 : (256 * (n0 >> 7) + (n0 & 127) + (mode == 2 ? 128 : 0));
    const int c = lane & 7;
#pragma unroll
    for (int j = 0; j < 8; ++j) { const int n = (lane >> 3) + 8 * j; const LAS unsigned char* sp = scr + (8 * c) * TRP + n * 2;
        unsigned short e[8];
#pragma unroll
        for (int q = 0; q < 8; ++q) e[q] = *(const LAS unsigned short*)(sp + q * TRP);
        u32x4 o; o.x = e[0] | ((unsigned)e[1] << 16); o.y = e[2] | ((unsigned)e[3] << 16); o.z = e[4] | ((unsigned)e[5] << 16); o.w = e[6] | ((unsigned)e[7] << 16);
        *(u32x4*)(WT + (size_t)(d0 + n) * K + k0 + 8 * c) = o; }
    LDS_WAIT(); asm volatile("" ::: "memory");
}
__device__ __forceinline__ void p0_prologue(Frame& F) {
    PHASE_IDS();
    LAS unsigned char* scr = F.lds + wave * 16384;
    const int gw = F.bid * 8 + wave, NGW = F.G * 8;
    const int gt = F.bid * 512 + tid, NGT = F.G * 512;
    constexpr int I_IN = (DM / 64) * (INC / 64), I_OUT = (DM / 64) * (DM / 64), I_G = (DM / 64) * (FF / 64), I_DN = (FF / 64) * (DM / 64), I_PP = (PLE / 64) * (DM / 64);
    constexpr int NITEMS = I_IN + I_OUT + 2 * I_G + I_DN + I_OUT + I_PP;
    for (int it = gw; it < NITEMS; it += NGW) {
        int r = it;
        if (r < I_IN) { p0_transpose_item(F_w_in, DM, INC, F_WIN, nullptr, 0, scr, r, lane); continue; } r -= I_IN;
        if (r < I_OUT) { p0_transpose_item(F_w_out, DM, DM, F_WOUT, nullptr, 0, scr, r, lane); continue; } r -= I_OUT;
        if (r < I_G) { p0_transpose_item(F_w_gate, DM, FF, F_WGU, F_norm_ffn_g, 1, scr, r, lane); continue; } r -= I_G;
        if (r < I_G) { p0_transpose_item(F_w_up, DM, FF, F_WGU, F_norm_ffn_g, 2, scr, r, lane); continue; } r -= I_G;
        if (r < I_DN) { p0_transpose_item(F_w_down, FF, DM, F_WDN, nullptr, 0, scr, r, lane); continue; } r -= I_DN;
        if (r < I_OUT) { p0_transpose_item(F_w_pg, DM, DM, F_WPG, F_norm_ple_g, 0, scr, r, lane); continue; } r -= I_OUT;
        p0_transpose_item(F_w_pp, PLE, DM, F_WPP, nullptr, 0, scr, r, lane);
    }
    {
        f32x4 gv[8];
#pragma unroll
        for (int j = 0; j < 8; ++j) gv[j] = *((const f32x4*)F_norm_mix_g + lane + 64 * j);
        for (int m = gw; m < M; m += 2 * NGW) {
            const int m2 = (m + NGW < M) ? m + NGW : m;
            const f32x4* xr = (const f32x4*)(F_x + (size_t)m * DM) + lane; const f32x4* xr2 = (const f32x4*)(F_x + (size_t)m2 * DM) + lane;
            f32x4 v[8], v2[8]; float sa = 0.f, sb = 0.f;
#pragma unroll
            for (int j = 0; j < 8; ++j) { v[j] = xr[64 * j]; v2[j] = xr2[64 * j]; }
#pragma unroll
            for (int j = 0; j < 8; ++j) { sa += (v[j][0] * v[j][0] + v[j][1] * v[j][1]) + (v[j][2] * v[j][2] + v[j][3] * v[j][3]); sb += (v2[j][0] * v2[j][0] + v2[j][1] * v2[j][1]) + (v2[j][2] * v2[j][2] + v2[j][3] * v2[j][3]); }
            const float rs = __builtin_amdgcn_rsqf(wave_sum(sa) * (1.0f / DM) + EPS), rs2 = __builtin_amdgcn_rsqf(wave_sum(sb) * (1.0f / DM) + EPS);
            u32x2* o = (u32x2*)(F_HB + (size_t)m * DM) + lane; u32x2* o2 = (u32x2*)(F_HB + (size_t)m2 * DM) + lane;
#pragma unroll
            for (int j = 0; j < 8; ++j) { u32x2 w; w.x = cvt_pk_bf16(v[j][0] * rs * gv[j][0], v[j][1] * rs * gv[j][1]); w.y = cvt_pk_bf16(v[j][2] * rs * gv[j][2], v[j][3] * rs * gv[j][3]); o[64 * j] = w;
                u32x2 w2; w2.x = cvt_pk_bf16(v2[j][0] * rs2 * gv[j][0], v2[j][1] * rs2 * gv[j][1]); w2.y = cvt_pk_bf16(v2[j][2] * rs2 * gv[j][2], v2[j][3] * rs2 * gv[j][3]); o2[64 * j] = w2; }
        }
    }
    for (int i = gt; i < M * PLE / 4; i += NGT) { const f32x4 v = ((const f32x4*)F_p)[i]; u32x2 w; w.x = cvt_pk_bf16(v[0], v[1]); w.y = cvt_pk_bf16(v[2], v[3]); ((u32x2*)F_PBF)[i] = w; }
    for (int i = gt; i < 8 * 128 * 128 / 4; i += NGT) { const f32x4 v = ((const f32x4*)F_sgu_w)[i]; u32x2 w; w.x = cvt_pk_bf16(v[0], v[1]); w.y = cvt_pk_bf16(v[2], v[3]); ((u32x2*)F_SGUW)[i] = w; }
    for (int i = gt; i < 2048; i += NGT) { const float* l = (i < 1024) ? F_lbfl : F_lbbl; const int c = i & 1023; const float a = l[c], b = l[1024 + c], mx = fmaxf(a, b), ea = __expf(a - mx), eb = __expf(b - mx);
        F_ctl[(i < 1024 ? CT_LBF : CT_LBB) + c] = ea / (ea + eb); }
    for (int i = gt; i < 5 * M; i += NGT) F_ctl[CT_VSUM + i] = 0.f;
}

__device__ __forceinline__ bf16x8 ldfrag(const LAS unsigned char* base, int pitch, int row, int kbyte) { return *(const LAS bf16x8*)(base + row * pitch + kbyte); }
#define MFMA16(a, b, c) __builtin_amdgcn_mfma_f32_16x16x32_bf16((b), (a), (c), 0, 0, 0)

constexpr int P128 = 272, P64 = 144;
constexpr int H_QT = 0, H_KT = H_QT + 64 * P128, H_QTB = H_KT + 64 * P128, H_KTB = H_QTB + 64 * P128, H_SS = H_KTB + 64 * P128, H_VT = H_SS + 128 * P128, H_PB = H_VT + 128 * P64, H_TOT = H_PB + 64 * P64, H_RSX = H_TOT + 4096, H_END = H_RSX + 512;
constexpr int H_RAWF = 0, H_RAWB = 16384, H_RAWQ = 32768, H_RAWV = 49152;
static_assert(H_RAWV + 16384 <= H_SS && H_END <= 147200, "raw alias / lds");
static_assert(H_END <= LDS_BYTES, "lds");

__device__ __forceinline__ u32x4 pack8(const float* v) { u32x4 w; w.x = cvt_pk_bf16(v[0], v[1]); w.y = cvt_pk_bf16(v[2], v[3]); w.z = cvt_pk_bf16(v[4], v[5]); w.w = cvt_pk_bf16(v[6], v[7]); return w; }
__device__ __forceinline__ int invperm32(int kk) { return 16 * ((kk >> 2) & 1) + (((kk >> 3) << 2) | (kk & 3)); }
__device__ __forceinline__ unsigned short lds_u16(const LAS unsigned char* p) { return *(const LAS unsigned short*)p; }

constexpr int NSEGC = 16, NSEG = BATCH * NHEAD * (NCHUNK / NSEGC);
constexpr int T_KT = 0, T_DL = 4 * 128 * P64, T_END = T_DL + 2048;
static_assert(T_END <= LDS_BYTES, "s1 lds");
__device__ __forceinline__ void unpack_lf16(const u32x4 (&r)[2], float (&o)[16]) {
#pragma unroll
    for (int q = 0; q < 2; ++q)
#pragma unroll
        for (int e = 0; e < 4; ++e) { o[8 * q + 2 * e] = h2f((unsigned short)(r[q][e] & 0xffffu)) * 1.4426950408889634f; o[8 * q + 2 * e + 1] = h2f((unsigned short)(r[q][e] >> 16)) * 1.4426950408889634f; }
}
__device__ __forceinline__ void hgrn_s1(Frame& F) {
    LAS unsigned char* lds = F.lds;
    PHASE_IDS();
    const int k = tid >> 2, tq = tid & 3, w = wave, fr = lane & 15, fq = lane >> 4;
    const int kr = (k & ~31) + invperm32(k & 31);
    const int lq = lane & ~3;
    u32x4 rlf[2], rlb[2], raf[2], rab[2];
#define S1_LOAD(bh_, cf_, cb_) do { const bf16_t* tf_ = F_PROJ + (size_t)(((bh_) >> 3) * 256 + (cf_)) * PT_CHUNK + ((bh_) & 7) * PT_TILE; const bf16_t* tb_ = F_PROJ + (size_t)(((bh_) >> 3) * 256 + (cb_)) * PT_CHUNK + ((bh_) & 7) * PT_TILE; \
        rlf[0] = *(const u32x4*)(tf_ + 1 * PT_SEG + k * 64 + 16 * tq); rlf[1] = *(const u32x4*)(tf_ + 1 * PT_SEG + k * 64 + 16 * tq + 8); \
        rlb[0] = *(const u32x4*)(tb_ + 2 * PT_SEG + k * 64 + 16 * tq); rlb[1] = *(const u32x4*)(tb_ + 2 * PT_SEG + k * 64 + 16 * tq + 8); \
        raf[0] = *(const u32x4*)(tf_ + 3 * PT_SEG + (16 * w + fr) * 64 + 8 * fq); raf[1] = *(const u32x4*)(tf_ + 3 * PT_SEG + (16 * w + fr) * 64 + 32 + 8 * fq); \
        rab[0] = *(const u32x4*)(tb_ + 3 * PT_SEG + (16 * w + fr) * 64 + 8 * fq); rab[1] = *(const u32x4*)(tb_ + 3 * PT_SEG + (16 * w + fr) * 64 + 32 + 8 * fq); } while (0)
    for (int sg = F.bid; sg < NSEG; sg += F.G) {
        const int bh = sg >> 4, seg = sg & 15;
        f32x4 Rf[4][2], Rb[4][2];
#pragma unroll
        for (int gg = 0; gg < 4; ++gg)
#pragma unroll
            for (int n = 0; n < 2; ++n) { Rf[gg][n] = (f32x4){0.f, 0.f, 0.f, 0.f}; Rb[gg][n] = (f32x4){0.f, 0.f, 0.f, 0.f}; }
        float cumf = 0.f, cumb = 0.f;
        S1_LOAD(bh, NSEGC * seg, NSEGC * seg + NSEGC - 1);
#pragma unroll 1
        for (int i = 0; i < NSEGC; ++i) {
            const int cf = NSEGC * seg + i, cb = NSEGC * seg + NSEGC - 1 - i, par = i & 1;
            float lff[16], lfb[16];
            unpack_lf16(rlf, lff); unpack_lf16(rlb, lfb);
            const bf16x8 a0f = __builtin_bit_cast(bf16x8, raf[0]), a1f = __builtin_bit_cast(bf16x8, raf[1]), a0b = __builtin_bit_cast(bf16x8, rab[0]), a1b = __builtin_bit_cast(bf16x8, rab[1]);
#pragma unroll
            for (int dir = 0; dir < 2; ++dir) {
                bf16_t* Sd = F_S + (size_t)((bh * 2 + dir) * 256 + (dir ? cb : cf)) * 16384 + (size_t)(16 * w + fr) * 128 + 8 * fq;
#pragma unroll
                for (int gg = 0; gg < 4; ++gg) { const f32x4 r0 = dir ? Rb[gg][0] : Rf[gg][0], r1 = dir ? Rb[gg][1] : Rf[gg][1];
                    u32x4 o; o.x = cvt_pk_bf16(r0[0], r0[1]); o.y = cvt_pk_bf16(r0[2], r0[3]); o.z = cvt_pk_bf16(r1[0], r1[1]); o.w = cvt_pk_bf16(r1[2], r1[3]);
                    *(u32x4*)(Sd + 32 * gg) = o; }
            }
            if (i + 1 < NSEGC) S1_LOAD(bh, cf + 1, cb - 1);
            float tf = 0.f, tb = 0.f;
#pragma unroll
            for (int j = 0; j < 16; ++j) { tf += lff[j]; tb += lfb[j]; }
            float offF = 0.f, offB = 0.f, totf = 0.f, totb = 0.f;
#pragma unroll
            for (int q = 0; q < 4; ++q) { const float a = __shfl(tf, lq + q), bb = __shfl(tb, lq + q); totf += a; totb += bb; if (q > tq) offF += a; if (q < tq) offB += bb; }
            float kh[16];
            {
                float run = offF, ep = __builtin_amdgcn_exp2f(run);
#pragma unroll
                for (int j = 15; j >= 0; --j) { run += lff[j]; const float en = __builtin_amdgcn_exp2f(run); kh[j] = ep - en; ep = en; }
                LAS unsigned char* dst = lds + T_KT + (par * 2 + 0) * 128 * P64 + kr * P64 + tq * 32;
                *(LAS u32x4*)dst = pack8(kh); *(LAS u32x4*)(dst + 16) = pack8(kh + 8);
            }
            {
                float run = offB, ep = __builtin_amdgcn_exp2f(run);
#pragma unroll
                for (int j = 0; j < 16; ++j) { run += lfb[j]; const float en = __builtin_amdgcn_exp2f(run); kh[j] = ep - en; ep = en; }
                LAS unsigned char* dst = lds + T_KT + (par * 2 + 1) * 128 * P64 + kr * P64 + tq * 32;
                *(LAS u32x4*)dst = pack8(kh); *(LAS u32x4*)(dst + 16) = pack8(kh + 8);
            }
            LAS float* DL = (LAS float*)(lds + T_DL) + par * 256;
            if (tq == 0) { F_DEC[(size_t)((bh * 2 + 0) * 256 + cf) * 128 + k] = __builtin_amdgcn_exp2f(cumf); DL[k] = __builtin_amdgcn_exp2f(totf); }
            if (tq == 1) { F_DEC[(size_t)((bh * 2 + 1) * 256 + cb) * 128 + k] = __builtin_amdgcn_exp2f(cumb); DL[128 + k] = __builtin_amdgcn_exp2f(totb); }
            cumf += totf; cumb += totb;
            LBAR();
#pragma unroll
            for (int dir = 0; dir < 2; ++dir) {
                const LAS unsigned char* kt = lds + T_KT + (par * 2 + dir) * 128 * P64;
                const bf16x8 a0 = dir ? a0b : a0f, a1 = dir ? a1b : a1f;
#pragma unroll
                for (int gg = 0; gg < 4; ++gg) {
                    f32x4 r0 = dir ? Rb[gg][0] : Rf[gg][0], r1 = dir ? Rb[gg][1] : Rf[gg][1];
                    const f32x4 d0 = *(const LAS f32x4*)(DL + dir * 128 + 32 * gg + 8 * fq), d1 = *(const LAS f32x4*)(DL + dir * 128 + 32 * gg + 8 * fq + 4);
                    r0 = r0 * d0; r1 = r1 * d1;
                    r0 = MFMA16(a0, ldfrag(kt, P64, 32 * gg + fr, fq * 16), r0);
                    r1 = MFMA16(a0, ldfrag(kt, P64, 32 * gg + 16 + fr, fq * 16), r1);
                    r0 = MFMA16(a1, ldfrag(kt, P64, 32 * gg + fr, 64 + fq * 16), r0);
                    r1 = MFMA16(a1, ldfrag(kt, P64, 32 * gg + 16 + fr, 64 + fq * 16), r1);
                    if (dir) { Rb[gg][0] = r0; Rb[gg][1] = r1; } else { Rf[gg][0] = r0; Rf[gg][1] = r1; }
                }
            }
        }
#pragma unroll
        for (int dir = 0; dir < 2; ++dir) {
            bf16_t* Sd = F_SEG + (size_t)((bh * 2 + dir) * 16 + seg) * 16384 + (size_t)(16 * w + fr) * 128 + 8 * fq;
#pragma unroll
            for (int gg = 0; gg < 4; ++gg) { const f32x4 r0 = dir ? Rb[gg][0] : Rf[gg][0], r1 = dir ? Rb[gg][1] : Rf[gg][1];
                u32x4 o; o.x = cvt_pk_bf16(r0[0], r0[1]); o.y = cvt_pk_bf16(r0[2], r0[3]); o.z = cvt_pk_bf16(r1[0], r1[1]); o.w = cvt_pk_bf16(r1[2], r1[3]);
                *(u32x4*)(Sd + 32 * gg) = o; }
        }
        if (tq == 0) F_DSEG[(size_t)((bh * 2 + 0) * 16 + seg) * 128 + k] = __builtin_amdgcn_exp2f(cumf);
        if (tq == 1) F_DSEG[(size_t)((bh * 2 + 1) * 16 + seg) * 128 + k] = __builtin_amdgcn_exp2f(cumb);
        LBAR();
    }
#undef S1_LOAD
}

__device__ __forceinline__ void hgrn_s2(Frame& F) {
    PHASE_IDS();
    for (int e = F.bid * 512 + tid; e < 32 * 4096; e += F.G * 512) {
        const int stream = e >> 12, off = (e & 4095) * 4, dir = stream & 1;
        const bf16_t* Sg = F_SEG + (size_t)stream * 16 * 16384 + off; bf16_t* Cg = F_CARRY + (size_t)stream * 16 * 16384 + off; const float* Dg = F_DSEG + (size_t)stream * 16 * 128 + (off & 127);
        u32x2 loc[16]; f32x4 dd[16];
#pragma unroll
        for (int u = 0; u < 16; ++u) { const int sx = dir ? 15 - u : u; loc[u] = *(const u32x2*)(Sg + (size_t)sx * 16384); dd[u] = *(const f32x4*)(Dg + (size_t)sx * 128); }
        f32x4 run = {0.f, 0.f, 0.f, 0.f};
#pragma unroll
        for (int u = 0; u < 16; ++u) { const int sx = dir ? 15 - u : u;
            u32x2 o; o.x = cvt_pk_bf16(run[0], run[1]); o.y = cvt_pk_bf16(run[2], run[3]); *(u32x2*)(Cg + (size_t)sx * 16384) = o;
            run[0] = dd[u][0] * run[0] + bflo(loc[u].x); run[1] = dd[u][1] * run[1] + bfhi(loc[u].x); run[2] = dd[u][2] * run[2] + bflo(loc[u].y); run[3] = dd[u][3] * run[3] + bfhi(loc[u].y); }
    }
}

__device__ __forceinline__ u32x4 comb8(u32x4 sp, u32x4 cr, f32x4 d0, f32x4 d1) {
    u32x4 o;
    o.x = cvt_pk_bf16(bflo(sp.x) + d0[0] * bflo(cr.x), bfhi(sp.x) + d0[1] * bfhi(cr.x)); o.y = cvt_pk_bf16(bflo(sp.y) + d0[2] * bflo(cr.y), bfhi(sp.y) + d0[3] * bfhi(cr.y));
    o.z = cvt_pk_bf16(bflo(sp.z) + d1[0] * bflo(cr.z), bfhi(sp.z) + d1[1] * bfhi(cr.z)); o.w = cvt_pk_bf16(bflo(sp.w) + d1[2] * bflo(cr.w), bfhi(sp.w) + d1[3] * bfhi(cr.w));
    return o;
}
__device__ __forceinline__ void hgrn_s3(Frame& F) {
    LAS unsigned char* lds = F.lds;
    PHASE_IDS();
    const int k = tid >> 2, tq = tid & 3, w = wave, fr = lane & 15, fq = lane >> 4;
    const int tb = w & 3, half = w >> 2, lq = lane & ~3;
    LAS float* RSX = (LAS float*)(lds + H_RSX);
    const int NL = F.bid < NSEG ? ((NSEG - F.bid + F.G - 1) / F.G) * NSEGC : 0;
    u32x4 rq[2], rlf[2], rlb[2], rv[2], rsf[4], rsb[4], rcf[4], rcb[4]; f32x4 dcf[2], dcb[2];
#define S3_DEC(L_, c_, bh_) const int sg_ = F.bid + ((L_) >> 4) * F.G; const int bh_ = sg_ >> 4, c_ = NSEGC * (sg_ & 15) + ((L_) & 15)
    const int pc8 = tid & 15;
#define S3_LOAD(it) do { S3_DEC(it, c_, bh_); const bf16_t* bp_ = F_PROJ + (size_t)((bh_ >> 3) * 256 + c_) * PT_CHUNK + (bh_ & 7) * PT_TILE; \
        _Pragma("unroll") for (int i_ = 0; i_ < 2; ++i_) { rq[i_] = *(const u32x4*)(bp_ + 0 * PT_SEG + k * 64 + 16 * tq + 8 * i_); rlf[i_] = *(const u32x4*)(bp_ + 1 * PT_SEG + k * 64 + 16 * tq + 8 * i_); rlb[i_] = *(const u32x4*)(bp_ + 2 * PT_SEG + k * 64 + 16 * tq + 8 * i_); \
            rv[i_] = *(const u32x4*)(bp_ + 3 * PT_SEG + (tid + 512 * i_) * 8); } } while (0)
#define S3_LOADS(it) do { S3_DEC(it, c_, bh_); const bf16_t* sf_ = F_S + (size_t)((bh_ * 2 + 0) * 256 + c_) * 16384 + tid * 8; const bf16_t* sb_ = F_S + (size_t)((bh_ * 2 + 1) * 256 + c_) * 16384 + tid * 8; \
        _Pragma("unroll") for (int i_ = 0; i_ < 4; ++i_) { rsf[i_] = *(const u32x4*)(sf_ + i_ * 4096); rsb[i_] = *(const u32x4*)(sb_ + i_ * 4096); } \
        const float* df_ = F_DEC + (size_t)((bh_ * 2 + 0) * 256 + c_) * 128 + pc8 * 8; const float* db_ = F_DEC + (size_t)((bh_ * 2 + 1) * 256 + c_) * 128 + pc8 * 8; \
        dcf[0] = *(const f32x4*)df_; dcf[1] = *(const f32x4*)(df_ + 4); dcb[0] = *(const f32x4*)db_; dcb[1] = *(const f32x4*)(db_ + 4); \
        if ((((it) & 15) == 0)) { const bf16_t* cf_ = F_CARRY + (size_t)((bh_ * 2 + 0) * 16 + (c_ >> 4)) * 16384 + tid * 8; const bf16_t* cb_ = F_CARRY + (size_t)((bh_ * 2 + 1) * 16 + (c_ >> 4)) * 16384 + tid * 8; \
            _Pragma("unroll") for (int i_ = 0; i_ < 4; ++i_) { rcf[i_] = *(const u32x4*)(cf_ + i_ * 4096); rcb[i_] = *(const u32x4*)(cb_ + i_ * 4096); } } } while (0)
    if (NL > 0) { S3_LOAD(0); S3_LOADS(0); }
    f32x4 ogv[2][2];
#pragma unroll
    for (int i = 0; i < 2; ++i) { ogv[i][0] = *(const f32x4*)(F_onorm_g + 64 * half + 32 * i + 8 * fq); ogv[i][1] = *(const f32x4*)(F_onorm_g + 64 * half + 32 * i + 8 * fq + 4); }
    u32x4 po[2]; bf16_t* pop = nullptr;
#pragma unroll 1
    for (int L = 0; L < NL; ++L) {
        S3_DEC(L, c, bh); const int h = bh & 7, b = bh >> 3;
        const size_t row0 = (size_t)b * SEQ + 64 * c;
        const bool has_next = L + 1 < NL;
        if (L > 0) { *(u32x4*)pop = po[0]; *(u32x4*)(pop + 32) = po[1]; }
        float lff[16], lfb[16], qv[16];
        unpack_lf16(rlf, lff); unpack_lf16(rlb, lfb);
#pragma unroll
        for (int q = 0; q < 2; ++q)
#pragma unroll
            for (int e = 0; e < 4; ++e) { qv[8 * q + 2 * e] = bflo(rq[q][e]); qv[8 * q + 2 * e + 1] = bfhi(rq[q][e]); }
#pragma unroll
        for (int i = 0; i < 2; ++i) { const int p = tid + 512 * i, d = p >> 3, c8 = p & 7, dr_ = (d & ~31) + invperm32(d & 31); *(LAS u32x4*)(lds + H_VT + dr_ * P64 + c8 * 16) = rv[i]; }
        if (has_next) S3_LOAD(L + 1);
        float offF = 0.f, offB = 0.f;
        {
            float tf = 0.f, tbw = 0.f;
#pragma unroll
            for (int j = 0; j < 16; ++j) { tf += lff[j]; tbw += lfb[j]; }
#pragma unroll
            for (int q = 0; q < 4; ++q) { const float a_ = __shfl(tf, lq + q), b_ = __shfl(tbw, lq + q); if (q < tq) offF += a_; if (q > tq) offB += b_; }
        }
        {
            float run = offF, rp = __builtin_amdgcn_exp2f(-run);
            float runb = offB, rpb = __builtin_amdgcn_exp2f(-runb);
#pragma unroll
            for (int j = 0; j < 16; ++j) { run += lff[j]; const int t = 16 * tq + j; const float rn = __builtin_amdgcn_exp2f(-run);
                *(LAS bf16_t*)(lds + H_QT + t * P128 + k * 2) = (bf16_t)(cvt_pk_bf16(qv[j] * __builtin_amdgcn_exp2f(run), 0.f) & 0xffff);
                *(LAS bf16_t*)(lds + H_KT + t * P128 + k * 2) = (bf16_t)(cvt_pk_bf16(rn - rp, 0.f) & 0xffff); rp = rn;
                const int jb = 15 - j, tb_ = 16 * tq + jb; runb += lfb[jb]; const float rnb = __builtin_amdgcn_exp2f(-runb);
                *(LAS bf16_t*)(lds + H_QTB + tb_ * P128 + k * 2) = (bf16_t)(cvt_pk_bf16(qv[jb] * __builtin_amdgcn_exp2f(runb), 0.f) & 0xffff);
                *(LAS bf16_t*)(lds + H_KTB + tb_ * P128 + k * 2) = (bf16_t)(cvt_pk_bf16(rnb - rpb, 0.f) & 0xffff); rpb = rnb; }
#pragma unroll
            for (int i = 0; i < 4; ++i) { const int p = tid + 512 * i, r = p >> 4, cc = p & 15, rr = (r & ~31) + invperm32(r & 31); *(LAS u32x4*)(lds + H_SS + rr * P128 + cc * 16) = comb8(rsf[i], rcf[i], dcf[0], dcf[1]); }
        }
        LBAR();
        f32x4 oacc[4];
#pragma unroll
        for (int i = 0; i < 4; ++i) oacc[i] = (f32x4){0.f, 0.f, 0.f, 0.f};
        {
            f32x4 pf[2], pb[2];
#pragma unroll
            for (int i = 0; i < 2; ++i) { pf[i] = (f32x4){0.f, 0.f, 0.f, 0.f}; pb[i] = (f32x4){0.f, 0.f, 0.f, 0.f}; }
#pragma unroll
            for (int ks = 0; ks < 4; ++ks) {
                const bf16x8 a = ldfrag(lds + H_QT, P128, 16 * tb + fr, ks * 64 + fq * 16), ab = ldfrag(lds + H_QTB, P128, 16 * tb + fr, ks * 64 + fq * 16);
#pragma unroll
                for (int i = 0; i < 2; ++i) { pf[i] = MFMA16(a, ldfrag(lds + H_KT, P128, 16 * (2 * half + i) + fr, ks * 64 + fq * 16), pf[i]); pb[i] = MFMA16(ab, ldfrag(lds + H_KTB, P128, 16 * (2 * half + i) + fr, ks * 64 + fq * 16), pb[i]); }
#pragma unroll
                for (int i = 0; i < 4; ++i) oacc[i] = MFMA16(a, ldfrag(lds + H_SS, P128, 16 * (4 * half + i) + fr, ks * 64 + fq * 16), oacc[i]);
            }
            const int t = 16 * tb + fr;
#pragma unroll
            for (int i = 0; i < 2; ++i) { const int s0 = 16 * (2 * half + i) + 4 * fq; float pv[4];
#pragma unroll
                for (int j = 0; j < 4; ++j) { const int s_ = s0 + j; pv[j] = (s_ <= t ? pf[i][j] : 0.f) + (s_ >= t ? pb[i][j] : 0.f); }
                u32x2 o; o.x = cvt_pk_bf16(pv[0], pv[1]); o.y = cvt_pk_bf16(pv[2], pv[3]);
                *(LAS u32x2*)(lds + H_PB + t * P64 + s0 * 2) = o; }
        }
        LBAR();
        u32x4 gw[2];
        {
#pragma unroll
            for (int i = 0; i < 4; ++i) { const int p = tid + 512 * i, r = p >> 4, cc = p & 15, rr = (r & ~31) + invperm32(r & 31); *(LAS u32x4*)(lds + H_SS + rr * P128 + cc * 16) = comb8(rsb[i], rcb[i], dcb[0], dcb[1]); }
            if (has_next) S3_LOADS(L + 1);
            const bf16_t* gp = F_PROJ + (size_t)(b * 256 + c) * PT_CHUNK + 4 * PT_SEG + h * PT_TILE + (16 * tb + fr) * 128 + 64 * half + 8 * fq;
#pragma unroll
            for (int i = 0; i < 2; ++i) gw[i] = *(const u32x4*)(gp + 32 * i);
        }
        LBAR();
#pragma unroll
        for (int ks = 0; ks < 4; ++ks) {
            const bf16x8 ab = ldfrag(lds + H_QTB, P128, 16 * tb + fr, ks * 64 + fq * 16);
#pragma unroll
            for (int i = 0; i < 4; ++i) oacc[i] = MFMA16(ab, ldfrag(lds + H_SS, P128, 16 * (4 * half + i) + fr, ks * 64 + fq * 16), oacc[i]);
        }
#pragma unroll
        for (int ks = 0; ks < 2; ++ks) {
            const bf16x8 a = ldfrag(lds + H_PB, P64, 16 * tb + fr, ks * 64 + fq * 16);
#pragma unroll
            for (int i = 0; i < 4; ++i) oacc[i] = MFMA16(a, ldfrag(lds + H_VT, P64, 16 * (4 * half + i) + fr, ks * 64 + fq * 16), oacc[i]);
        }
        {
            const int t = 16 * tb + fr;
            float ss = 0.f;
#pragma unroll
            for (int i = 0; i < 4; ++i) ss += (oacc[i][0] * oacc[i][0] + oacc[i][1] * oacc[i][1]) + (oacc[i][2] * oacc[i][2] + oacc[i][3] * oacc[i][3]);
            ss += __shfl_xor(ss, 16); ss += __shfl_xor(ss, 32);
            if (fq == 0) RSX[half * 64 + t] = ss;
            LBAR();
            const float rs = __builtin_amdgcn_rsqf((RSX[t] + RSX[64 + t]) * (1.0f / 128.0f) + EPS);
            bf16_t* op = F_CAT + (row0 + t) * DM + h * 128;
#pragma unroll
            for (int i = 0; i < 2; ++i) { const int d = 64 * half + 32 * i + 8 * fq;
                const f32x4 og0 = ogv[i][0], og1 = ogv[i][1]; (void)d;
                const f32x4 e0 = oacc[2 * i], e1 = oacc[2 * i + 1];
                u32x4 o; o.x = cvt_pk_bf16(e0[0] * rs * og0[0] * bflo(gw[i].x), e0[1] * rs * og0[1] * bfhi(gw[i].x));
                o.y = cvt_pk_bf16(e0[2] * rs * og0[2] * bflo(gw[i].y), e0[3] * rs * og0[3] * bfhi(gw[i].y));
                o.z = cvt_pk_bf16(e1[0] * rs * og1[0] * bflo(gw[i].z), e1[1] * rs * og1[1] * bfhi(gw[i].z));
                o.w = cvt_pk_bf16(e1[2] * rs * og1[2] * bflo(gw[i].w), e1[3] * rs * og1[3] * bfhi(gw[i].w));
                po[i] = o; }
            pop = op + 64 * half + 8 * fq;
        }
    }
    if (NL > 0) { *(u32x4*)pop = po[0]; *(u32x4*)(pop + 32) = po[1]; }
#undef S3_LOAD
#undef S3_LOADS
#undef S3_DEC
}

constexpr int G_RAW = 0, G_WL = 32768, G_VT = G_WL + 2 * 128 * P128, G_STAT = G_VT + 128 * P128;
static_assert(G_STAT + 1024 <= LDS_BYTES, "sgu lds");
__device__ __forceinline__ void sgu_phase(Frame& F) {
    LAS unsigned char* lds = F.lds;
    PHASE_IDS();
    const int d_e = tid & 127, sq = tid >> 7, w = wave, fr = lane & 15, fq = lane >> 4;
    LAS f32x2* STAT = (LAS f32x2*)(lds + G_STAT);
    const int dr = (d_e & ~31) + invperm32(d_e & 31);
    const float* vsum = F_ctl + CT_VSUM; const float* vssq = F_ctl + CT_VSSQ;
    u32x4 rvp[4], rw[4], uwn[4]; float lgn, lbn, bsn;
#define SGU_LOAD(r0_, g_) do { const bf16_t* vp_ = F_PROJ + (size_t)((r0_) >> 6) * PT_CHUNK + 6 * PT_SEG + (g_) * PT_TILE + (tid >> 4) * 128 + (tid & 15) * 8; const bf16_t* wp_ = F_SGUW + (size_t)(g_) * 16384 + tid * 8; \
        _Pragma("unroll") for (int i_ = 0; i_ < 4; ++i_) { rvp[i_] = *(const u32x4*)(vp_ + (size_t)(i_ >> 1) * PT_CHUNK + (i_ & 1) * 32 * 128); rw[i_] = *(const u32x4*)(wp_ + i_ * 4096); } \
        lgn = F_ln_g[(g_) * 128 + d_e]; lbn = F_ln_b[(g_) * 128 + d_e]; bsn = F_sgu_b[(g_) * 128 + 16 * w + fr]; \
        const bf16_t* up_ = F_PROJ + (size_t)(((r0_) >> 6) + (w >> 2)) * PT_CHUNK + 5 * PT_SEG + (g_) * PT_TILE + (16 * (w & 3) + fr) * 128 + 8 * fq; \
        _Pragma("unroll") for (int i_ = 0; i_ < 4; ++i_) uwn[i_] = *(const u32x4*)(up_ + 32 * i_); } while (0)
    for (int item = F.bid; item < M / 128; item += F.G) {
        const size_t r0 = (size_t)item * 128;
        SGU_LOAD(r0, 0);
        if (tid < 128) { const float mu = vsum[r0 + tid] * (1.0f / 1024.0f); const float var = vssq[r0 + tid] * (1.0f / 1024.0f) - mu * mu; STAT[tid] = (f32x2){mu, __builtin_amdgcn_rsqf(fmaxf(var, 0.f) + EPS)}; }
        const int t = 16 * w + fr;
        float ssq = 0.f;
#pragma unroll 1
        for (int g = 0; g < 8; ++g) {
            const int wl = G_WL + (g & 1) * 128 * P128;
            const float lg = lgn, lb = lbn, bs = bsn; u32x4 uw[4];
#pragma unroll
            for (int i = 0; i < 4; ++i) uw[i] = uwn[i];
#pragma unroll
            for (int i = 0; i < 4; ++i) { const int p = tid + 512 * i, r = p >> 4, cc = p & 15;
                *(LAS u32x4*)(lds + G_RAW + r * 256 + cc * 16) = rvp[i]; *(LAS u32x4*)(lds + wl + r * P128 + cc * 16) = rw[i]; }
            if (g < 7) SGU_LOAD(r0, g + 1);
            LBAR();
            {
#pragma unroll
                for (int i = 0; i < 4; ++i) { float y[8];
#pragma unroll
                    for (int j = 0; j < 8; ++j) { const int s_ = 32 * sq + 8 * i + j; const f32x2 st = STAT[s_]; y[j] = (bf2f(lds_u16(lds + G_RAW + s_ * 256 + d_e * 2)) - st[0]) * st[1] * lg + lb; }
                    *(LAS u32x4*)(lds + G_VT + dr * P128 + (32 * sq + 8 * i) * 2) = pack8(y); }
            }
            LBAR();
            bf16x8 a[4];
#pragma unroll
            for (int ks = 0; ks < 4; ++ks) a[ks] = ldfrag(lds + wl, P128, 16 * w + fr, ks * 64 + fq * 16);
            bf16_t* op = F_CAT + (r0 + t) * DM + 1024 + g * 128 + 8 * fq;
#pragma unroll
            for (int gg = 0; gg < 4; ++gg) {
                f32x4 acc0 = {0.f, 0.f, 0.f, 0.f}, acc1 = {0.f, 0.f, 0.f, 0.f};
#pragma unroll
                for (int ks = 0; ks < 4; ++ks) { acc0 = MFMA16(a[ks], ldfrag(lds + G_VT, P128, 32 * gg + fr, ks * 64 + fq * 16), acc0); acc1 = MFMA16(a[ks], ldfrag(lds + G_VT, P128, 32 * gg + 16 + fr, ks * 64 + fq * 16), acc1); }
                const u32x4 uq = uw[gg];
                const float v0 = bflo(uq.x) * (acc0[0] + bs), v1 = bfhi(uq.x) * (acc0[1] + bs), v2 = bflo(uq.y) * (acc0[2] + bs), v3 = bfhi(uq.y) * (acc0[3] + bs);
                const float v4 = bflo(uq.z) * (acc1[0] + bs), v5 = bfhi(uq.z) * (acc1[1] + bs), v6 = bflo(uq.w) * (acc1[2] + bs), v7 = bfhi(uq.w) * (acc1[3] + bs);
                ssq += (v0 * v0 + v1 * v1) + (v2 * v2 + v3 * v3) + (v4 * v4 + v5 * v5) + (v6 * v6 + v7 * v7);
                u32x4 o; o.x = cvt_pk_bf16(v0, v1); o.y = cvt_pk_bf16(v2, v3); o.z = cvt_pk_bf16(v4, v5); o.w = cvt_pk_bf16(v6, v7);
                *(u32x4*)(op + 32 * gg) = o;
            }
        }
        ssq += __shfl_xor(ssq, 16); ssq += __shfl_xor(ssq, 32);
        const float rs = __builtin_amdgcn_rsqf(ssq * (1.0f / 1024.0f) + EPS);
        asm volatile("s_waitcnt vmcnt(0)" ::: "memory");
#pragma unroll 1
        for (int gh = 0; gh < 2; ++gh) {
            bf16_t* op = F_CAT + (r0 + t) * DM + 1024 + gh * 512 + 8 * fq; const float* og = F_sgu_onorm + gh * 512 + 8 * fq;
            u32x4 vw[16];
#pragma unroll
            for (int q = 0; q < 16; ++q) vw[q] = *(const u32x4*)(op + 32 * q);
#pragma unroll
            for (int q = 0; q < 16; ++q) { const f32x4 o4 = *(const f32x4*)(og + 32 * q), o5 = *(const f32x4*)(og + 32 * q + 4);
                u32x4 o; o.x = cvt_pk_bf16(bflo(vw[q].x) * rs * o4[0], bfhi(vw[q].x) * rs * o4[1]); o.y = cvt_pk_bf16(bflo(vw[q].y) * rs * o4[2], bfhi(vw[q].y) * rs * o4[3]);
                o.z = cvt_pk_bf16(bflo(vw[q].z) * rs * o5[0], bfhi(vw[q].z) * rs * o5[1]); o.w = cvt_pk_bf16(bflo(vw[q].w) * rs * o5[2], bfhi(vw[q].w) * rs * o5[3]);
                *(u32x4*)(op + 32 * q) = o; }
        }
        LBAR();
    }
#undef SGU_LOAD
}

__device__ __forceinline__ void final_norm(Frame& F) {
    PHASE_IDS();
    const int gw = F.bid * 8 + wave, NGW = F.G * 8;
    const float* ssq = F_ctl + CT_SSQ3;
    f32x4 gv[8];
#pragma unroll
    for (int j = 0; j < 8; ++j) gv[j] = *((const f32x4*)F_final_g + lane + 64 * j);
    for (int m = gw; m < M; m += 2 * NGW) {
        const int m2 = (m + NGW < M) ? m + NGW : m;
        const float rs = __builtin_amdgcn_rsqf(ssq[m] * (1.0f / DM) + EPS), rs2 = __builtin_amdgcn_rsqf(ssq[m2] * (1.0f / DM) + EPS);
        const u32x2* hr = (const u32x2*)(F_H3B + (size_t)m * DM) + lane; const u32x2* hr2 = (const u32x2*)(F_H3B + (size_t)m2 * DM) + lane;
        f32x4* xr = (f32x4*)(F.out + (size_t)m * DM) + lane; f32x4* xr2 = (f32x4*)(F.out + (size_t)m2 * DM) + lane;
        u32x2 hv[8], hv2[8];
#pragma unroll
        for (int j = 0; j < 8; ++j) { hv[j] = hr[64 * j]; hv2[j] = hr2[64 * j]; }
#pragma unroll
        for (int j = 0; j < 8; ++j) { f32x4 v = {bflo(hv[j].x), bfhi(hv[j].x), bflo(hv[j].y), bfhi(hv[j].y)}; v = v * rs * gv[j]; xr[64 * j] = v;
            f32x4 v2 = {bflo(hv2[j].x), bfhi(hv2[j].x), bflo(hv2[j].y), bfhi(hv2[j].y)}; v2 = v2 * rs2 * gv[j]; xr2[64 * j] = v2; }
    }
}

#define XB_TMO      128
#define XB_XCNT(j)  (256  + 64 * (j))
#define XB_XSUB(j)  (1280 + 64 * (j))
#define XB_XGEN(j)  (2304 + 64 * (j))
#define XB_TOP      3328
#define XB_TOPGEN   3392
#define XCD_BAR_WORDS 3456
#define XB_SPIN_CAP (1u << 18)

__device__ __forceinline__ unsigned xb_ld(unsigned* p)              { return __hip_atomic_load(p, __ATOMIC_RELAXED, __HIP_MEMORY_SCOPE_AGENT); }
__device__ __forceinline__ unsigned xb_add(unsigned* p, unsigned v) { return __hip_atomic_fetch_add(p, v, __ATOMIC_RELAXED, __HIP_MEMORY_SCOPE_AGENT); }
__device__ __forceinline__ unsigned xb_xcc_id() { return (unsigned)__builtin_amdgcn_s_getreg((3 << 11) | 20) & 0xFu; }
#define XB_SPIN(cond, bar) do { unsigned _sp = 0; while (cond) { __builtin_amdgcn_s_sleep(1); \
    if ((++_sp & 255u) == 0u) { if (xb_ld(&(bar)[XB_TMO])) break; if (_sp > XB_SPIN_CAP) { atomicAdd(&(bar)[XB_TMO], 1u); break; } } } } while (0)

struct XcdBarrier {
    unsigned* bar; unsigned x;
    volatile LAS unsigned* st;
};

__device__ __forceinline__ XcdBarrier xcd_barrier_post(unsigned* bar, volatile LAS unsigned* st) {
    XcdBarrier b; b.bar = bar; b.x = xb_xcc_id(); b.st = st;
    if (threadIdx.x == 0) (void)xb_add(&bar[XB_XCNT(b.x)], 1u);
    return b;
}
__device__ __forceinline__ void xcd_barrier_complete(unsigned* bar, unsigned x, unsigned& nloc, unsigned& nx) {
    const unsigned G = gridDim.x * gridDim.y * gridDim.z;
    unsigned sum, cnt, mine, sp = 0u;
    for (;;) {
        sum = 0u; cnt = 0u; mine = 0u;
#pragma unroll
        for (unsigned j = 0; j < 16; ++j) { const unsigned c = xb_ld(&bar[XB_XCNT(j)]); sum += c; cnt += (c > 0u) ? 1u : 0u; mine = (j == x) ? c : mine; }
        if (sum == G) break;
        __builtin_amdgcn_s_sleep(1);
        if ((++sp & 255u) == 0u) { if (xb_ld(&bar[XB_TMO])) break; if (sp > XB_SPIN_CAP) { atomicAdd(&bar[XB_TMO], 1u); break; } }
    }
    nloc = mine > 0u ? mine : 1u; nx = cnt > 0u ? cnt : 1u;
}

__device__ __forceinline__ void xcd_barrier(const XcdBarrier& b) {
    asm volatile("s_waitcnt vmcnt(0)" ::: "memory");
    __syncthreads();
    if (threadIdx.x == 0) {
        unsigned* bar = b.bar;
        __builtin_amdgcn_s_waitcnt(0);
        unsigned nloc = b.st[0], nx = b.st[1];
        if (nloc == 0u) { xcd_barrier_complete(bar, b.x, nloc, nx); b.st[0] = nloc; b.st[1] = nx; }
        const unsigned old = xb_add(&bar[XB_XSUB(b.x)], 1u);
        const unsigned gen = old / nloc;
        if (old + 1u == (gen + 1u) * nloc) {
            __builtin_amdgcn_fence(__ATOMIC_RELEASE, "agent");
            asm volatile("s_waitcnt vmcnt(0)" ::: "memory");
            const unsigned og = xb_add(&bar[XB_TOP], 1u);
            const unsigned tg = og / nx;
            if (og + 1u == (tg + 1u) * nx) xb_add(&bar[XB_TOPGEN], 1u);
            else XB_SPIN(xb_ld(&bar[XB_TOPGEN]) == tg, bar);
            __builtin_amdgcn_fence(__ATOMIC_ACQUIRE, "agent");
            xb_add(&bar[XB_XGEN(b.x)], 1u);
            asm volatile("s_waitcnt vmcnt(0)" ::: "memory");
        } else {
            XB_SPIN(xb_ld(&bar[XB_XGEN(b.x)]) == gen, bar);
            __builtin_amdgcn_fence(__ATOMIC_ACQUIRE, "agent");
            asm volatile("s_waitcnt vmcnt(0)" ::: "memory");
        }
    }
    __syncthreads();
}


constexpr int N_PHASES = 10;
__global__ void __launch_bounds__(512) mk_fwd(Args args) {
    extern __shared__ __attribute__((aligned(16))) unsigned char lds_raw[];
    Frame F;
    F.lds = (LAS unsigned char*)lds_raw;
    F.G = gridDim.x; F.bid = blockIdx.x;
    F.in = args.in; F.out = args.out; F.ws = args.ws;
    cg::grid_group grid = cg::this_grid();
    volatile LAS unsigned* bst = (volatile LAS unsigned*)(F.lds + LDS_BARST);
    if (threadIdx.x < 2) bst[threadIdx.x] = 0u;
    __syncthreads();
    const XcdBarrier bar = xcd_barrier_post((unsigned*)(args.ws + WS_BAR), bst);
    const int lo = args.ph_lo, hi = args.ph_hi;
#define IN(k) (lo <= (k) && (k) < hi)
#define SEAM(k) do { if (IN(k) && IN((k) + 1)) xcd_barrier(bar); } while (0)
    if (lo < 0) grid.sync();

    if (IN(0)) { p0_prologue(F); }
    SEAM(0);
    if (IN(1)) {
        { pg8::Gemm g{F_WIN, F_HB, 4096, M, DM}; pg8::StaticOrder S; S.init(4096, M, F.G, F.bid);
          EpiInT E{F_PROJ, F_ctl + CT_LBF, F_ctl + CT_LBB};
          pg8::gemm_phase<EpiInT, pg8::StaticOrder>(F.lds, g, S, E); }
        { pg8::Gemm g{F_HB, F_WIN + (size_t)4096 * DM, M, INC - 4096, DM}; pg8::StaticOrder S; S.init(M, INC - 4096, F.G, F.bid);
          EpiIn E{F_PROJ, F_ctl + CT_LBF, F_ctl + CT_LBB, F_ctl + CT_VSUM, F_ctl + CT_VSSQ, 4};
          pg8::gemm_phase<EpiIn, pg8::StaticOrder>(F.lds, g, S, E); }
    }
    SEAM(1);
    if (IN(2)) { hgrn_s1(F); __syncthreads(); sgu_phase(F); }
    SEAM(2);
    if (IN(3)) { hgrn_s2(F); }
    SEAM(3);
    if (IN(4)) { hgrn_s3(F); }
    SEAM(4);
    if (IN(5)) {
        pg8::Gemm g{F_CAT, F_WOUT, M, DM, DM}; pg8::StaticOrder S; S.init(M, DM, F.G, F.bid);
        EpiRes<false> E{F_x, F_HB, F_ctl + CT_SSQ1};
        pg8::gemm_phase<EpiRes<false>, pg8::StaticOrder>(F.lds, g, S, E);
    }
    SEAM(5);
    if (IN(6)) {
        { pg8::Gemm g{F_HB, F_WGU, M, 2 * FF, DM}; pg8::StaticOrder S; S.init(M, 2 * FF, F.G, F.bid);
          EpiGU E{F_ACT, F_ctl + CT_SSQ1};
          pg8::gemm_phase<EpiGU, pg8::StaticOrder>(F.lds, g, S, E); }
        { pg8::Gemm g{F_PBF, F_WPP, M, DM, PLE}; pg8::StaticOrder S; S.init(M, DM, F.G, F.bid);
          EpiPP E{F_PP};
          pg8::gemm_phase<EpiPP, pg8::StaticOrder>(F.lds, g, S, E); }
    }
    SEAM(6);
    if (IN(7)) {
        pg8::Gemm g{F_ACT, F_WDN, M, DM, FF}; pg8::StaticOrder S; S.init(M, DM, F.G, F.bid);
        EpiRes<true> E{nullptr, F_HB, F_ctl + CT_SSQ2};
        pg8::gemm_phase<EpiRes<true>, pg8::StaticOrder>(F.lds, g, S, E);
    }
    SEAM(7);
    if (IN(8)) {
        pg8::Gemm g{F_HB, F_WPG, M, DM, DM}; pg8::StaticOrder S; S.init(M, DM, F.G, F.bid);
        EpiPle E{F_HB, F_H3B, F_PP, F_ctl + CT_SSQ2, F_ctl + CT_SSQ3};
        pg8::gemm_phase<EpiPle, pg8::StaticOrder>(F.lds, g, S, E);
    }
    SEAM(8);
    if (IN(9)) { final_norm(F); }
#undef IN
#undef SEAM
}

extern "C" void kernel_launch(void* const* d_in, const int* in_sizes, int n_in, void* d_out, int out_size, void* d_ws, size_t ws_size, hipStream_t stream) {
    static int grid = 0;
    if (grid == 0) {
        if (n_in != 21 || out_size != M * DM || ws_size < WS_END) { fprintf(stderr, "kernel_launch: unexpected sizes n_in %d out %d ws %zu\n", n_in, out_size, ws_size); grid = -1; return; }
        int dev = 0, cus = 0, per_cu = 0;
        hipGetDevice(&dev); hipDeviceGetAttribute(&cus, hipDeviceAttributeMultiprocessorCount, dev);
        if (hipFuncSetAttribute((const void*)mk_fwd, hipFuncAttributeMaxDynamicSharedMemorySize, LDS_BYTES) != hipSuccess) { fprintf(stderr, "kernel_launch: hipFuncSetAttribute failed\n"); grid = -1; return; }
        if (hipOccupancyMaxActiveBlocksPerMultiprocessor(&per_cu, (const void*)mk_fwd, 512, LDS_BYTES) != hipSuccess || per_cu < 1) { fprintf(stderr, "kernel_launch: occupancy query gave %d\n", per_cu); per_cu = 1; }
        (void)hipGetLastError();
        grid = cus * 1;
        fprintf(stderr, "kernel_launch: cus %d per_cu %d grid %d\n", cus, per_cu, grid);
    }
    if (grid < 0) return;
    if (hipMemsetAsync((char*)d_ws + WS_BAR, 0, XCD_BAR_WORDS * 4, stream) != hipSuccess) { fprintf(stderr, "kernel_launch: memset of barrier words failed\n"); return; }
    Args a{};
    for (int i = 0; i < 21; ++i) a.in[i] = (const float*)d_in[i];
    a.out = (float*)d_out; a.ws = (unsigned char*)d_ws;
#if MK_N_LAUNCHES == 1
    a.ph_lo = 0; a.ph_hi = N_PHASES;
    void* kargs[] = {&a};
    hipError_t e = hipLaunchCooperativeKernel((const void*)mk_fwd, dim3(grid), dim3(512), kargs, LDS_BYTES, stream);
    if (e != hipSuccess) fprintf(stderr, "kernel_launch: cooperative launch failed: %s (grid %d)\n", hipGetErrorString(e), grid);
#else
    for (int ph = 0; ph < N_PHASES; ++ph) {
        a.ph_lo = ph; a.ph_hi = ph + 1;
        void* kargs[] = {&a};
        hipError_t e = hipLaunchCooperativeKernel((const void*)mk_fwd, dim3(grid), dim3(512), kargs, LDS_BYTES, stream);
        if (e != hipSuccess) { fprintf(stderr, "kernel_launch: launch %d failed: %s (grid %d)\n", ph, hipGetErrorString(e), grid); break; }
    }
#endif
}
```

```cpp
#include <hip/hip_runtime.h>
#include <hip/hip_cooperative_groups.h>
#include <cstdio>
#include <cstdint>
namespace cg = cooperative_groups;

#ifndef MK_N_LAUNCHES
#define MK_N_LAUNCHES 1
#endif

#define LAS __attribute__((address_space(3)))
typedef unsigned short bf16_t;
typedef short bf16x8 __attribute__((ext_vector_type(8)));
typedef float f32x4 __attribute__((ext_vector_type(4)));
typedef float f32x2 __attribute__((ext_vector_type(2)));
typedef unsigned u32x4 __attribute__((ext_vector_type(4)));
typedef unsigned u32x2 __attribute__((ext_vector_type(2)));

constexpr int BATCH = 2, SEQ = 16384, M = BATCH * SEQ, DM = 2048, INC = 7168, FF = 5632, PLE = 256;
constexpr int NHEAD = 8, NCHUNK = SEQ / 64;
constexpr float EPS = 1e-6f;
constexpr int C_Q = 0, C_ZF = 1024, C_ZB = 2048, C_I = 3072, C_G = 4096, C_U = 5120, C_V = 6144;
constexpr size_t PT_TILE = 8192, PT_SEG = 8 * PT_TILE, PT_CHUNK = 7 * PT_SEG;

constexpr size_t MiB = 1u << 20;
constexpr size_t WS_CTL = 0;
constexpr size_t WS_WIN = 1 * MiB, WS_WOUT = 29 * MiB, WS_WGU = 37 * MiB, WS_WDN = 81 * MiB, WS_WPG = 103 * MiB, WS_WPP = 111 * MiB, WS_SGUW = 112 * MiB;
constexpr size_t WS_PBF = 113 * MiB, WS_DEC = 129 * MiB, WS_PROJ = 133 * MiB, WS_CAT = 581 * MiB, WS_HB = 709 * MiB, WS_SEG = 965 * MiB, WS_CARRY = 981 * MiB, WS_DSEG = 997 * MiB, WS_END = 998 * MiB;
constexpr size_t WS_ACT = WS_PROJ, WS_PP = WS_CAT, WS_S = WS_HB;
constexpr int CT_LBF = 0, CT_LBB = 1024, CT_VSUM = 16384, CT_VSSQ = CT_VSUM + M, CT_SSQ1 = CT_VSSQ + M, CT_SSQ2 = CT_SSQ1 + M, CT_SSQ3 = CT_SSQ2 + M;
static_assert((size_t)(CT_SSQ3 + M) * 4 <= 1 * MiB, "ctl");

constexpr int LDS_BYTES = 163840;
constexpr size_t WS_BAR = 768 * 1024;
constexpr int LDS_BARST = 163584;

typedef __bf16 bf16v2 __attribute__((ext_vector_type(2)));
__device__ __forceinline__ unsigned cvt_pk_bf16(float lo, float hi) { const f32x2 v = {lo, hi}; const bf16v2 r = __builtin_convertvector(v, bf16v2); return __builtin_bit_cast(unsigned, r); }
__device__ __forceinline__ float bf2f(unsigned short h) { return __uint_as_float((unsigned)h << 16); }
__device__ __forceinline__ float bflo(unsigned w) { return __uint_as_float(w << 16); }
__device__ __forceinline__ float bfhi(unsigned w) { return __uint_as_float(w & 0xffff0000u); }
__device__ __forceinline__ float h2f(unsigned short h) { return (float)__builtin_bit_cast(_Float16, h); }
__device__ __forceinline__ unsigned short f2h(float f) { return __builtin_bit_cast(unsigned short, (_Float16)f); }
__device__ __forceinline__ float fsigmoid(float x) { return __builtin_amdgcn_rcpf(1.0f + __expf(-x)); }
__device__ __forceinline__ float fsilu(float x) { return x * fsigmoid(x); }
__device__ __forceinline__ float wave_sum(float v) {
#pragma unroll
    for (int o = 1; o < 64; o <<= 1) v += __shfl_xor(v, o);
    return v;
}
__device__ __forceinline__ void atomic_addf(float* p, float v) { __hip_atomic_fetch_add(p, v, __ATOMIC_RELAXED, __HIP_MEMORY_SCOPE_AGENT); }
__device__ __forceinline__ float gelu1(float v) {
    const float av = __builtin_fabsf(v), t = __builtin_amdgcn_rcpf(av * 0.2316418882f + 1.0f);
    float q = t * 0.5307027145f + (-0.7265760135f); q = q * t + 0.7107068705f; q = q * t + (-0.142248368f); q = q * t + 0.127414796f; q = q * t;
    const float e = __builtin_amdgcn_exp2f((v * v) * (-0.72134752044f));
    const float m = v * (q * e);
    return v < 0.f ? m : v - m;
}

__device__ __forceinline__ int fresh_tid();
typedef _Float16 f16v2 __attribute__((ext_vector_type(2)));
__device__ __forceinline__ f32x2 exp2_pk(f32x2 v) { f32x2 r; r.x = __builtin_amdgcn_exp2f(v.x); r.y = __builtin_amdgcn_exp2f(v.y); return r; }
__device__ __forceinline__ f32x2 rcp_pk(f32x2 v) { f32x2 r; r.x = __builtin_amdgcn_rcpf(v.x); r.y = __builtin_amdgcn_rcpf(v.y); return r; }
__device__ __forceinline__ f32x2 log2_pk(f32x2 v) { f32x2 r; r.x = __builtin_amdgcn_logf(v.x); r.y = __builtin_amdgcn_logf(v.y); return r; }
__device__ __forceinline__ f32x2 sigmoid_pk(f32x2 x) { return rcp_pk(exp2_pk(x * (-1.4426950408889634f)) + 1.0f); }
__device__ __forceinline__ f32x2 silu_pk(f32x2 x) { return x * sigmoid_pk(x); }
__device__ __forceinline__ f32x2 gelu_pk(f32x2 v) {
    const f32x2 av = __builtin_elementwise_abs(v), d = av * 0.2316418882f + 1.0f;
    const f32x2 t = rcp_pk(d);
    f32x2 q = t * 0.5307027145f + (-0.7265760135f); q = q * t + 0.7107068705f; q = q * t + (-0.142248368f); q = q * t + 0.127414796f; q = q * t;
    const f32x2 e = exp2_pk((v * v) * (-0.72134752044f));
    const f32x2 m = v * (q * e), r = v - m;
    f32x2 o; o.x = v.x < 0.f ? m.x : r.x; o.y = v.y < 0.f ? m.y : r.y; return o;
}
__device__ __forceinline__ unsigned cvt_pk_bf16v(f32x2 v) { const bf16v2 r = __builtin_convertvector(v, bf16v2); return __builtin_bit_cast(unsigned, r); }
__device__ __forceinline__ unsigned cvt_pk_f16v(f32x2 v) { const f16v2 r = __builtin_convertvector(v, f16v2); return __builtin_bit_cast(unsigned, r); }
namespace pg8 {
constexpr int BM = 256, BK = 64, HALF = 128, HTB = HALF * BK * 2, STAGE_BYTES = 8 * HTB, NXCD = 8, WGM = 8;
__host__ __device__ __forceinline__ int lds_byte(int r, int c) { const int st = (r >> 4) * 2 + (c >> 5), rr = r & 15, cc = c & 31, ob = rr * 64 + cc * 2; return st * 1024 + (ob ^ (((ob >> 9) & 1) << 5)); }
__host__ __device__ __forceinline__ void stage_rc(int b, int& R, int& C) { const int st = b / 1024, sb = b % 1024, swz = sb ^ (((sb >> 9) & 1) << 5); R = (st >> 1) * 16 + swz / 64; C = (st & 1) * 32 + (swz % 64) / 2; }
__host__ __device__ __forceinline__ int perm32(int rho) { const int n = rho >> 4, i = rho & 15; return 8 * (i >> 2) + 4 * n + (i & 3); }

struct Unit { int pm, pn; };
struct Gemm { const bf16_t* A; const bf16_t* Bt; int M, N, K; };

struct StaticOrder {
    int nM, nN, nwg, G, c;
    __host__ __device__ __forceinline__ void init(int M_, int N_, int G_, int c_) { nM = M_ / BM; nN = N_ / BM; nwg = nM * nN; G = G_; c = c_; }
    __host__ __device__ __forceinline__ bool next(int i, Unit& u) const {
        const long L = (long)i * G + c; if (L >= nwg) return false;
        int wgid = (int)L; { const int q = nwg / NXCD, r = nwg % NXCD, xcd = wgid % NXCD, off = wgid / NXCD; wgid = (xcd < r ? xcd * (q + 1) : r * (q + 1) + (xcd - r) * q) + off; }
        const int nig = WGM * nN, gid = wgid / nig, fm = gid * WGM, gsz = (nM - fm) < WGM ? (nM - fm) : WGM;
        u.pm = fm + ((wgid % nig) % gsz); u.pn = (wgid % nig) / gsz; return true;
    }
};

typedef f32x4 Acc[2][2][4][2];

template <class Epi, class Sched, bool ALIGN_EPI = true>
__device__ __forceinline__ void gemm_phase(LAS unsigned char* lds, const Gemm g, const Sched& S, const Epi& E) {
    const int tid = fresh_tid(), wid = __builtin_amdgcn_readfirstlane(tid >> 6), lane = tid & 63, wr = wid >> 2, wc = wid & 3, fr = lane & 15, fq = lane >> 4;
    const int K = g.K, nt = K / BK;
    unsigned voffA[2], voffB[2];
#pragma unroll
    for (int i = 0; i < 2; ++i) { int R, C; stage_rc(tid * 16 + i * 8192, R, C); const int Rb = Epi::PERM ? ((R & ~31) + perm32(R & 31)) : R;
        voffA[i] = (unsigned)(R * K + C) * 2u; voffB[i] = (unsigned)(Rb * K + C) * 2u; }
    const size_t kstep = (size_t)(BK * 2);
    const size_t hstep = (size_t)HALF * K * 2;
    const size_t tstep = 2 * hstep;
    const unsigned ldsw = (unsigned)wid * 1024u;
    const int aoff = lds_byte(wr * 64 + fr, fq * 8), boff = lds_byte(wc * 32 + fr, fq * 8);
#define PG8_SA(b, h) (((b) * 2 + (h)) * HTB)
#define PG8_SB(b, h) ((4 + (b) * 2 + (h)) * HTB)
#define PG8_STAGE(bufoff, gbase, voff) do { _Pragma("unroll") for (int _i = 0; _i < 2; ++_i) \
        __builtin_amdgcn_global_load_lds((const unsigned*)((const char*)(gbase) + (voff)[_i]), (LAS unsigned*)(lds + (bufoff) + ldsw + _i * 8192), 16, 0, 0); } while (0)
#define PG8_LDA(dst, b, h) do { _Pragma("unroll") for (int m = 0; m < 4; ++m) _Pragma("unroll") for (int k = 0; k < 2; ++k) dst[m][k] = *(const LAS bf16x8*)(lds + PG8_SA(b, h) + aoff + m * 2048 + k * 1024); } while (0)
#define PG8_LDB(dst, b, h) do { _Pragma("unroll") for (int n = 0; n < 2; ++n) _Pragma("unroll") for (int k = 0; k < 2; ++k) dst[n][k] = *(const LAS bf16x8*)(lds + PG8_SB(b, h) + boff + n * 2048 + k * 1024); } while (0)
#define PG8_MMA(ai, bj, At, Bt) do { __builtin_amdgcn_s_setprio(1); _Pragma("unroll") for (int m = 0; m < 4; ++m) _Pragma("unroll") for (int n = 0; n < 2; ++n) _Pragma("unroll") for (int k = 0; k < 2; ++k) \
        acc[ai][bj][m][n] = __builtin_amdgcn_mfma_f32_16x16x32_bf16(Bt[n][k], At[m][k], acc[ai][bj][m][n], 0, 0, 0); __builtin_amdgcn_s_setprio(0); } while (0)
#define PG8_WAIT_V(n) asm volatile("s_waitcnt vmcnt(" #n ")" ::: "memory")
#define PG8_WAIT_L(n) asm volatile("s_waitcnt lgkmcnt(" #n ")" ::: "memory")
#define PG8_BAR __builtin_amdgcn_s_barrier()
#define PG8_SCHED __builtin_amdgcn_sched_barrier(0)
    Unit cur, nxt; int ui = 0;
    if (!S.next(0, cur)) return;
    Acc acc;
#pragma unroll
    for (int a = 0; a < 2; ++a)
#pragma unroll
        for (int b = 0; b < 2; ++b)
#pragma unroll
            for (int m = 0; m < 4; ++m)
#pragma unroll
                for (int n = 0; n < 2; ++n) acc[a][b][m][n] = (f32x4){0.f, 0.f, 0.f, 0.f};
    bf16x8 At[4][2], B0[2][2], B1[2][2];
    const char* cA = (const char*)g.A + (size_t)cur.pm * tstep; const char* cB = (const char*)g.Bt + (size_t)cur.pn * tstep;
    PG8_STAGE(PG8_SB(0, 0), cB, voffB); PG8_STAGE(PG8_SB(0, 1), cB + hstep, voffB); PG8_STAGE(PG8_SA(0, 0), cA, voffA); PG8_STAGE(PG8_SA(0, 1), cA + hstep, voffA);
    if (wr == 1) PG8_BAR;
    PG8_WAIT_V(2); PG8_BAR;
    PG8_STAGE(PG8_SB(1, 0), cB + kstep, voffB); PG8_STAGE(PG8_SA(1, 0), cA + kstep, voffA); PG8_STAGE(PG8_SB(1, 1), cB + hstep + kstep, voffB);
    PG8_WAIT_V(6); PG8_BAR;
    for (;;) {
        const bool has_next = S.next(ui + 1, nxt);
        const char* nA = has_next ? (const char*)g.A + (size_t)nxt.pm * tstep : cA; const char* nB = has_next ? (const char*)g.Bt + (size_t)nxt.pn * tstep : cB;
        for (int t = 0; t < nt; t += 2) {
            const bool last = (t == nt - 2);
            const char* a1 = cA + (size_t)(t + 1) * kstep;
            const char* a2 = last ? nA : cA + (size_t)(t + 2) * kstep; const char* b2 = last ? nB : cB + (size_t)(t + 2) * kstep;
            const char* a3 = a2 + kstep; const char* b3 = b2 + kstep;
            PG8_LDB(B0, 0, 0); PG8_LDB(B1, 0, 1); PG8_SCHED; PG8_LDA(At, 0, 0); PG8_STAGE(PG8_SA(1, 1), a1 + hstep, voffA);
            PG8_WAIT_V(8); PG8_WAIT_L(0); PG8_BAR; PG8_MMA(0, 0, At, B0); PG8_MMA(0, 1, At, B1); PG8_BAR; PG8_SCHED;
            PG8_LDA(At, 0, 1); PG8_STAGE(PG8_SB(0, 0), b2, voffB); PG8_STAGE(PG8_SB(0, 1), b2 + hstep, voffB); PG8_STAGE(PG8_SA(0, 0), a2, voffA);
            PG8_WAIT_V(8); PG8_WAIT_L(0); PG8_BAR; PG8_MMA(1, 0, At, B0); PG8_MMA(1, 1, At, B1); PG8_BAR; PG8_SCHED;
            PG8_LDB(B0, 1, 0); PG8_LDB(B1, 1, 1); PG8_SCHED; PG8_LDA(At, 1, 0); PG8_STAGE(PG8_SA(0, 1), a2 + hstep, voffA);
            PG8_WAIT_V(8); PG8_WAIT_L(0); PG8_BAR; PG8_MMA(0, 0, At, B0); PG8_MMA(0, 1, At, B1); PG8_BAR; PG8_SCHED;
            PG8_LDA(At, 1, 1); PG8_STAGE(PG8_SB(1, 0), b3, voffB); PG8_STAGE(PG8_SB(1, 1), b3 + hstep, voffB); PG8_STAGE(PG8_SA(1, 0), a3, voffA);
            PG8_WAIT_V(8); PG8_WAIT_L(0); PG8_BAR; PG8_MMA(1, 0, At, B0); PG8_MMA(1, 1, At, B1); PG8_BAR; PG8_SCHED;
        }
        if constexpr (ALIGN_EPI) { if (wr == 0) PG8_BAR; }
        E(acc, cur, wr, wc, fr, fq);
        if (!has_next) break;
#pragma unroll
        for (int a = 0; a < 2; ++a)
#pragma unroll
            for (int b = 0; b < 2; ++b)
#pragma unroll
                for (int m = 0; m < 4; ++m)
#pragma unroll
                    for (int n = 0; n < 2; ++n) acc[a][b][m][n] = (f32x4){0.f, 0.f, 0.f, 0.f};
        cur = nxt; cA = nA; cB = nB; ++ui;
        if constexpr (ALIGN_EPI) { if (wr == 1) PG8_BAR; }
    }
    PG8_WAIT_V(0);
    if constexpr (!ALIGN_EPI) { if (wr == 0) PG8_BAR; }
    PG8_BAR;
#undef PG8_SA
#undef PG8_SB
#undef PG8_STAGE
#undef PG8_LDA
#undef PG8_LDB
#undef PG8_MMA
#undef PG8_WAIT_V
#undef PG8_WAIT_L
#undef PG8_BAR
#undef PG8_SCHED
}
}
using pg8::Acc; using pg8::Unit;

#define EPI_FENCE() asm volatile("" ::: "memory")

struct EpiIn {
    static constexpr bool PERM = true;
    bf16_t* O; const float* lbf; const float* lbb; float* vsum; float* vssq; int seg_base;
    template <int SEG> __device__ __forceinline__ void body(const Acc& acc, const Unit& u, int wr, int wc, int fr, int fq) const {
        const int row0 = u.pm * 256 + wr * 64 + fr, col0 = u.pn * 256 + wc * 32 + 8 * fq;
        f32x2 lb[2][4], oml[2][4];
        if (SEG == 1 || SEG == 2) {
            const float* lp = (SEG == 1 ? lbf : lbb) + (col0 - SEG * 1024);
#pragma unroll
            for (int bj = 0; bj < 2; ++bj)
#pragma unroll
                for (int e = 0; e < 4; ++e) { lb[bj][e] = (f32x2){lp[bj * 128 + 2 * e], lp[bj * 128 + 2 * e + 1]}; oml[bj][e] = 1.0f - lb[bj][e]; }
        }
#pragma unroll
        for (int ai = 0; ai < 2; ++ai)
#pragma unroll
            for (int m = 0; m < 4; ++m) {
                const int row = row0 + ai * 128 + m * 16;
                bf16_t* rowp = O + (size_t)(u.pm * 4 + ai * 2 + wr) * PT_CHUNK + (size_t)SEG * PT_SEG + (size_t)((u.pn & 3) * 2) * PT_TILE + (m * 16 + fr) * 128 + wc * 32 + 8 * fq;
                f32x2 s1 = {0.f, 0.f}, s2 = {0.f, 0.f};
#pragma unroll
                for (int bj = 0; bj < 2; ++bj) {
                    f32x2 v[4];
                    v[0] = (f32x2){acc[ai][bj][m][0][0], acc[ai][bj][m][0][1]}; v[1] = (f32x2){acc[ai][bj][m][0][2], acc[ai][bj][m][0][3]};
                    v[2] = (f32x2){acc[ai][bj][m][1][0], acc[ai][bj][m][1][1]}; v[3] = (f32x2){acc[ai][bj][m][1][2], acc[ai][bj][m][1][3]};
                    u32x4 w;
                    if (SEG == 1 || SEG == 2) {
                        unsigned hw[4];
#pragma unroll
                        for (int e = 0; e < 4; ++e) { const f32x2 f = lb[bj][e] + oml[bj][e] * sigmoid_pk(v[e]); hw[e] = cvt_pk_f16v(log2_pk(f) * 0.6931471805599453f); }
                        w.x = hw[0]; w.y = hw[1]; w.z = hw[2]; w.w = hw[3];
                    } else {
#pragma unroll
                        for (int e = 0; e < 4; ++e) {
                            if (SEG == 0 || SEG == 4) v[e] = silu_pk(v[e]);
                            if (SEG == 5 || SEG == 6) v[e] = gelu_pk(v[e]);
                            if (SEG == 6) { s1 += v[e]; s2 += v[e] * v[e]; }
                        }
                        w.x = cvt_pk_bf16v(v[0]); w.y = cvt_pk_bf16v(v[1]); w.z = cvt_pk_bf16v(v[2]); w.w = cvt_pk_bf16v(v[3]);
                    }
                    *(u32x4*)(rowp + bj * PT_TILE) = w;
                    EPI_FENCE();
                }
                if (SEG == 6) {
                    float a1 = s1.x + s1.y, a2 = s2.x + s2.y;
                    a1 += __shfl_xor(a1, 16); a1 += __shfl_xor(a1, 32); a2 += __shfl_xor(a2, 16); a2 += __shfl_xor(a2, 32);
                    if (fq == 0) { atomic_addf(vsum + row, a1); atomic_addf(vssq + row, a2); }
                }
            }
    }
    __device__ __forceinline__ void operator()(const Acc& acc, const Unit& u, int wr, int wc, int fr, int fq) const {
        switch ((u.pn >> 2) + seg_base) {
            case 0: body<0>(acc, u, wr, wc, fr, fq); break;
            case 1: body<1>(acc, u, wr, wc, fr, fq); break;
            case 2: body<2>(acc, u, wr, wc, fr, fq); break;
            case 3: body<3>(acc, u, wr, wc, fr, fq); break;
            case 4: body<4>(acc, u, wr, wc, fr, fq); break;
            case 5: body<5>(acc, u, wr, wc, fr, fq); break;
            default: body<6>(acc, u, wr, wc, fr, fq); break;
        }
    }
};
struct EpiInT {
    static constexpr bool PERM = true;
    bf16_t* O; const float* lbf; const float* lbb;
    template <int SEG> __device__ __forceinline__ void body(const Acc& acc, const Unit& u, int wr, int wc, int fr, int fq) const {
        const int chunk0 = u.pn * 4 + (wc >> 1), s0 = 32 * (wc & 1) + 8 * fq;
        float lbv[2][4];
        if (SEG == 1 || SEG == 2) {
            const float* lp = (SEG == 1 ? lbf : lbb) + (u.pm & 3) * 256 + 64 * wr + fr;
#pragma unroll
            for (int ai = 0; ai < 2; ++ai)
#pragma unroll
                for (int m = 0; m < 4; ++m) lbv[ai][m] = lp[ai * 128 + 16 * m];
        }
#pragma unroll
        for (int ai = 0; ai < 2; ++ai)
#pragma unroll
            for (int m = 0; m < 4; ++m) {
                const int hh = (u.pm & 3) * 2 + ai, kk = 64 * wr + 16 * m + fr;
                bf16_t* tp = O + (size_t)SEG * PT_SEG + (size_t)hh * PT_TILE + kk * 64 + s0;
                const float l = (SEG == 1 || SEG == 2) ? lbv[ai][m] : 0.f, oml = 1.0f - l;
#pragma unroll
                for (int bj = 0; bj < 2; ++bj) {
                    f32x2 v[4];
                    v[0] = (f32x2){acc[ai][bj][m][0][0], acc[ai][bj][m][0][1]}; v[1] = (f32x2){acc[ai][bj][m][0][2], acc[ai][bj][m][0][3]};
                    v[2] = (f32x2){acc[ai][bj][m][1][0], acc[ai][bj][m][1][1]}; v[3] = (f32x2){acc[ai][bj][m][1][2], acc[ai][bj][m][1][3]};
                    u32x4 w;
                    if (SEG == 1 || SEG == 2) {
                        unsigned hw[4];
#pragma unroll
                        for (int e = 0; e < 4; ++e) { const f32x2 f = sigmoid_pk(v[e]) * oml + l; hw[e] = cvt_pk_f16v(log2_pk(f) * 0.6931471805599453f); }
                        w.x = hw[0]; w.y = hw[1]; w.z = hw[2]; w.w = hw[3];
                    } else {
                        if (SEG == 0) {
#pragma unroll
                            for (int e = 0; e < 4; ++e) v[e] = silu_pk(v[e]);
                        }
                        w.x = cvt_pk_bf16v(v[0]); w.y = cvt_pk_bf16v(v[1]); w.z = cvt_pk_bf16v(v[2]); w.w = cvt_pk_bf16v(v[3]);
                    }
                    *(u32x4*)(tp + (size_t)(chunk0 + 2 * bj) * PT_CHUNK) = w;
                    EPI_FENCE();
                }
            }
    }
    __device__ __forceinline__ void operator()(const Acc& acc, const Unit& u, int wr, int wc, int fr, int fq) const {
        switch (u.pm >> 2) {
            case 0: body<0>(acc, u, wr, wc, fr, fq); break;
            case 1: body<1>(acc, u, wr, wc, fr, fq); break;
            case 2: body<2>(acc, u, wr, wc, fr, fq); break;
            default: body<3>(acc, u, wr, wc, fr, fq); break;
        }
    }
};
template <bool BB> struct EpiRes {
    static constexpr bool PERM = true;
    const float* base; bf16_t* hb; float* ssq;
    __device__ __forceinline__ void operator()(const Acc& acc, const Unit& u, int wr, int wc, int fr, int fq) const {
        const int row0 = u.pm * 256 + wr * 64 + fr, col0 = u.pn * 256 + wc * 32 + 8 * fq;
#pragma unroll
        for (int ai = 0; ai < 2; ++ai) {
            f32x4 bv[4][2][2]; u32x4 bw[4][2];
#pragma unroll
            for (int m = 0; m < 4; ++m) { const size_t off = (size_t)(row0 + ai * 128 + m * 16) * DM + col0;
#pragma unroll
                for (int bj = 0; bj < 2; ++bj) {
                    if (BB) bw[m][bj] = *(const u32x4*)(hb + off + bj * 128);
                    else { bv[m][bj][0] = *(const f32x4*)(base + off + bj * 128); bv[m][bj][1] = *(const f32x4*)(base + off + bj * 128 + 4); } } }
            EPI_FENCE();
#pragma unroll
            for (int m = 0; m < 4; ++m) {
                const int row = row0 + ai * 128 + m * 16; const size_t off = (size_t)row * DM + col0;
                float s2 = 0.f;
#pragma unroll
                for (int bj = 0; bj < 2; ++bj) {
                    f32x4 b0, b1;
                    if (BB) { const u32x4 q = bw[m][bj]; b0 = (f32x4){bflo(q.x), bfhi(q.x), bflo(q.y), bfhi(q.y)}; b1 = (f32x4){bflo(q.z), bfhi(q.z), bflo(q.w), bfhi(q.w)}; }
                    else { b0 = bv[m][bj][0]; b1 = bv[m][bj][1]; }
                    const f32x4 h0 = b0 + acc[ai][bj][m][0], h1 = b1 + acc[ai][bj][m][1];
                    u32x4 w; w.x = cvt_pk_bf16(h0[0], h0[1]); w.y = cvt_pk_bf16(h0[2], h0[3]); w.z = cvt_pk_bf16(h1[0], h1[1]); w.w = cvt_pk_bf16(h1[2], h1[3]);
                    *(u32x4*)(hb + off + bj * 128) = w;
                    s2 += (h0[0] * h0[0] + h0[1] * h0[1]) + (h0[2] * h0[2] + h0[3] * h0[3]) + (h1[0] * h1[0] + h1[1] * h1[1]) + (h1[2] * h1[2] + h1[3] * h1[3]);
                }
                s2 += __shfl_xor(s2, 16); s2 += __shfl_xor(s2, 32);
                if (fq == 0) atomic_addf(ssq + row, s2);
            }
            EPI_FENCE();
        }
    }
};
struct EpiGU {
    static constexpr bool PERM = true;
    bf16_t* act; const float* ssq;
    __device__ __forceinline__ void operator()(const Acc& acc, const Unit& u, int wr, int wc, int fr, int fq) const {
        const int row0 = u.pm * 256 + wr * 64 + fr, col0 = u.pn * 128 + wc * 32 + 8 * fq;
        float rsv[2][4];
#pragma unroll
        for (int ai = 0; ai < 2; ++ai)
#pragma unroll
            for (int m = 0; m < 4; ++m) rsv[ai][m] = ssq[row0 + ai * 128 + m * 16];
        EPI_FENCE();
#pragma unroll
        for (int ai = 0; ai < 2; ++ai)
#pragma unroll
            for (int m = 0; m < 4; ++m) {
                const int row = row0 + ai * 128 + m * 16;
                const float rs = __builtin_amdgcn_rsqf(rsv[ai][m] * (1.0f / DM) + EPS);
                const float nrs = rs * (-1.4426950408889634f), rs2 = rs * rs;
                unsigned ow[4];
#pragma unroll
                for (int e = 0; e < 4; ++e) {
                    const f32x2 g2 = {acc[ai][0][m][e >> 1][2 * (e & 1)], acc[ai][0][m][e >> 1][2 * (e & 1) + 1]}, u2 = {acc[ai][1][m][e >> 1][2 * (e & 1)], acc[ai][1][m][e >> 1][2 * (e & 1) + 1]};
                    ow[e] = cvt_pk_bf16v((g2 * u2) * (rcp_pk(exp2_pk(g2 * nrs) + 1.0f) * rs2));
                }
                u32x4 w; w.x = ow[0]; w.y = ow[1]; w.z = ow[2]; w.w = ow[3];
                *(u32x4*)(act + (size_t)row * FF + col0) = w;
                EPI_FENCE();
            }
    }
};
struct EpiPP {
    static constexpr bool PERM = true;
    bf16_t* O;
    __device__ __forceinline__ void operator()(const Acc& acc, const Unit& u, int wr, int wc, int fr, int fq) const {
        const int row0 = u.pm * 256 + wr * 64 + fr, col0 = u.pn * 256 + wc * 32 + 8 * fq;
#pragma unroll
        for (int ai = 0; ai < 2; ++ai)
#pragma unroll
            for (int m = 0; m < 4; ++m) {
                bf16_t* rowp = O + (size_t)(row0 + ai * 128 + m * 16) * DM + col0;
#pragma unroll
                for (int bj = 0; bj < 2; ++bj) {
                    const f32x4 v0 = acc[ai][bj][m][0], v1 = acc[ai][bj][m][1];
                    u32x4 w; w.x = cvt_pk_bf16(v0[0], v0[1]); w.y = cvt_pk_bf16(v0[2], v0[3]); w.z = cvt_pk_bf16(v1[0], v1[1]); w.w = cvt_pk_bf16(v1[2], v1[3]);
                    *(u32x4*)(rowp + bj * 128) = w;
                    EPI_FENCE();
                }
            }
    }
};
struct EpiPle {
    static constexpr bool PERM = true;
    const bf16_t* hb; bf16_t* h3b; const bf16_t* pp; const float* ssq_in; float* ssq_out;
    __device__ __forceinline__ void operator()(const Acc& acc, const Unit& u, int wr, int wc, int fr, int fq) const {
        const int row0 = u.pm * 256 + wr * 64 + fr, col0 = u.pn * 256 + wc * 32 + 8 * fq;
#pragma unroll
        for (int ai = 0; ai < 2; ++ai) {
            u32x4 bw[4][2], pw[4][2]; float rsv[4];
#pragma unroll
            for (int m = 0; m < 4; ++m) { const int row = row0 + ai * 128 + m * 16; const size_t off = (size_t)row * DM + col0;
                rsv[m] = ssq_in[row];
#pragma unroll
                for (int bj = 0; bj < 2; ++bj) { bw[m][bj] = *(const u32x4*)(hb + off + bj * 128); pw[m][bj] = *(const u32x4*)(pp + off + bj * 128); } }
            EPI_FENCE();
#pragma unroll
            for (int m = 0; m < 4; ++m) {
                const int row = row0 + ai * 128 + m * 16; const size_t off = (size_t)row * DM + col0;
                const float rs = __builtin_amdgcn_rsqf(rsv[m] * (1.0f / DM) + EPS);
                float s2 = 0.f;
#pragma unroll
                for (int bj = 0; bj < 2; ++bj) {
                    const u32x4 q = bw[m][bj], pq = pw[m][bj];
                    f32x4 h0, h1;
                    h0[0] = bflo(q.x) + fsigmoid(acc[ai][bj][m][0][0] * rs) * bflo(pq.x); h0[1] = bfhi(q.x) + fsigmoid(acc[ai][bj][m][0][1] * rs) * bfhi(pq.x);
                    h0[2] = bflo(q.y) + fsigmoid(acc[ai][bj][m][0][2] * rs) * bflo(pq.y); h0[3] = bfhi(q.y) + fsigmoid(acc[ai][bj][m][0][3] * rs) * bfhi(pq.y);
                    h1[0] = bflo(q.z) + fsigmoid(acc[ai][bj][m][1][0] * rs) * bflo(pq.z); h1[1] = bfhi(q.z) + fsigmoid(acc[ai][bj][m][1][1] * rs) * bfhi(pq.z);
                    h1[2] = bflo(q.w) + fsigmoid(acc[ai][bj][m][1][2] * rs) * bflo(pq.w); h1[3] = bfhi(q.w) + fsigmoid(acc[ai][bj][m][1][3] * rs) * bfhi(pq.w);
                    u32x4 w; w.x = cvt_pk_bf16(h0[0], h0[1]); w.y = cvt_pk_bf16(h0[2], h0[3]); w.z = cvt_pk_bf16(h1[0], h1[1]); w.w = cvt_pk_bf16(h1[2], h1[3]);
                    *(u32x4*)(h3b + off + bj * 128) = w;
                    s2 += (h0[0] * h0[0] + h0[1] * h0[1]) + (h0[2] * h0[2] + h0[3] * h0[3]) + (h1[0] * h1[0] + h1[1] * h1[1]) + (h1[2] * h1[2] + h1[3] * h1[3]);
                }
                s2 += __shfl_xor(s2, 16); s2 += __shfl_xor(s2, 32);
                if (fq == 0) atomic_addf(ssq_out + row, s2);
            }
            EPI_FENCE();
        }
    }
};

struct Args { const float* in[21]; float* out; unsigned char* ws; int ph_lo, ph_hi; };
struct Frame {
    LAS unsigned char* lds; int G, bid;
    const float* const* in; float* out; unsigned char* ws;
};
__device__ __forceinline__ int fresh_tid() { int t = threadIdx.x; asm volatile("" : "+v"(t)); return t; }
#define PHASE_IDS() const int tid = fresh_tid(), lane = tid & 63, wave = __builtin_amdgcn_readfirstlane(tid >> 6); (void)lane; (void)wave
#define F_IN(i) (F.in[i])
#define F_x F_IN(0)
#define F_p F_IN(1)
#define F_norm_mix_g F_IN(2)
#define F_w_in F_IN(3)
#define F_lbfl F_IN(4)
#define F_lbbl F_IN(5)
#define F_onorm_g F_IN(6)
#define F_ln_g F_IN(7)
#define F_ln_b F_IN(8)
#define F_sgu_w F_IN(9)
#define F_sgu_b F_IN(10)
#define F_sgu_onorm F_IN(11)
#define F_w_out F_IN(12)
#define F_norm_ffn_g F_IN(13)
#define F_w_gate F_IN(14)
#define F_w_up F_IN(15)
#define F_w_down F_IN(16)
#define F_norm_ple_g F_IN(17)
#define F_w_pg F_IN(18)
#define F_w_pp F_IN(19)
#define F_final_g F_IN(20)
#define F_ctl ((float*)(F.ws + WS_CTL))
#define F_WIN ((bf16_t*)(F.ws + WS_WIN))
#define F_WOUT ((bf16_t*)(F.ws + WS_WOUT))
#define F_WGU ((bf16_t*)(F.ws + WS_WGU))
#define F_WDN ((bf16_t*)(F.ws + WS_WDN))
#define F_WPG ((bf16_t*)(F.ws + WS_WPG))
#define F_WPP ((bf16_t*)(F.ws + WS_WPP))
#define F_SGUW ((bf16_t*)(F.ws + WS_SGUW))
#define F_PBF ((bf16_t*)(F.ws + WS_PBF))
#define F_PROJ ((bf16_t*)(F.ws + WS_PROJ))
#define F_CAT ((bf16_t*)(F.ws + WS_CAT))
#define F_HB ((bf16_t*)(F.ws + WS_HB))
#define F_ACT ((bf16_t*)(F.ws + WS_ACT))
#define F_PP ((bf16_t*)(F.ws + WS_PP))
#define F_S ((bf16_t*)(F.ws + WS_S))
#define F_H3B ((bf16_t*)(F.ws + WS_ACT))
#define F_DEC ((float*)(F.ws + WS_DEC))
#define F_SEG ((bf16_t*)(F.ws + WS_SEG))
#define F_CARRY ((bf16_t*)(F.ws + WS_CARRY))
#define F_DSEG ((float*)(F.ws + WS_DSEG))
#define LDS_WAIT() asm volatile("s_waitcnt lgkmcnt(0)" ::: "memory")
#define LBAR() do { asm volatile("s_waitcnt lgkmcnt(0)" ::: "memory"); __builtin_amdgcn_s_barrier(); asm volatile("" ::: "memory"); } while (0)

constexpr int TRP = 136;
__device__ __forceinline__ void p0_transpose_item(const float* W, int K, int N, bf16_t* WT, const float* ksc, int mode, LAS unsigned char* scr, int item, int lane) {
    const int nblk = N / 64, kb = item / nblk, nb = item % nblk, k0 = 64 * kb, n0 = 64 * nb;
    const int lr = lane >> 4, lc = lane & 15;
#pragma unroll 8
    for (int i = 0; i < 16; ++i) { const int kk = 4 * i + lr; f32x4 v = *(const f32x4*)(W + (size_t)(k0 + kk) * N + n0 + 4 * lc); if (ksc) v = v * ksc[k0 + kk];
        u32x2 w; w.x = cvt_pk_bf16(v[0], v[1]); w.y = cvt_pk_bf16(v[2], v[3]); *(LAS u32x2*)(scr + kk * TRP + lc * 8) = w; }
    LDS_WAIT(); asm volatile("" ::: "memory");
    const int d0 = mode == 0 ? n0 : (256 * (n0 >> 7) + (n0 & 127) + (mode == 2 ? 128 : 0));
    const int c = lane & 7;
#pragma unroll
    for (int j = 0; j < 8; ++j) { const int n = (lane >> 3) + 8 * j; const LAS unsigned char* sp = scr + (8 * c) * TRP + n * 2;
        unsigned short e[8];
#pragma unroll
        for (int q = 0; q < 8; ++q) e[q] = *(const LAS unsigned short*)(sp + q * TRP);
        u32x4 o; o.x = e[0] | ((unsigned)e[1] << 16); o.y = e[2] | ((unsigned)e[3] << 16); o.z = e[4] | ((unsigned)e[5] << 16); o.w = e[6] | ((unsigned)e[7] << 16);
        *(u32x4*)(WT + (size_t)(d0 + n) * K + k0 + 8 * c) = o; }
    LDS_WAIT(); asm volatile("" ::: "memory");
}
__device__ __forceinline__ void p0_prologue(Frame& F) {
    PHASE_IDS();
    LAS unsigned char* scr = F.lds + wave * 16384;
    const int gw = F.bid * 8 + wave, NGW = F.G * 8;
    const int gt = F.bid * 512 + tid, NGT = F.G * 512;
    constexpr int I_IN = (DM / 64) * (INC / 64), I_OUT = (DM / 64) * (DM / 64), I_G = (DM / 64) * (FF / 64), I_DN = (FF / 64) * (DM / 64), I_PP = (PLE / 64) * (DM / 64);
    constexpr int NITEMS = I_IN + I_OUT + 2 * I_G + I_DN + I_OUT + I_PP;
    for (int it = gw; it < NITEMS; it += NGW) {
        int r = it;
        if (r < I_IN) { p0_transpose_item(F_w_in, DM, INC, F_WIN, nullptr, 0, scr, r, lane); continue; } r -= I_IN;
        if (r < I_OUT) { p0_transpose_item(F_w_out, DM, DM, F_WOUT, nullptr, 0, scr, r, lane); continue; } r -= I_OUT;
        if (r < I_G) { p0_transpose_item(F_w_gate, DM, FF, F_WGU, F_norm_ffn_g, 1, scr, r, lane); continue; } r -= I_G;
        if (r < I_G) { p0_transpose_item(F_w_up, DM, FF, F_WGU, F_norm_ffn_g, 2, scr, r, lane); continue; } r -= I_G;
        if (r < I_DN) { p0_transpose_item(F_w_down, FF, DM, F_WDN, nullptr, 0, scr, r, lane); continue; } r -= I_DN;
        if (r < I_OUT) { p0_transpose_item(F_w_pg, DM, DM, F_WPG, F_norm_ple_g, 0, scr, r, lane); continue; } r -= I_OUT;
        p0_transpose_item(F_w_pp, PLE, DM, F_WPP, nullptr, 0, scr, r, lane);
    }
    {
        f32x4 gv[8];
#pragma unroll
        for (int j = 0; j < 8; ++j) gv[j] = *((const f32x4*)F_norm_mix_g + lane + 64 * j);
        for (int m = gw; m < M; m += 2 * NGW) {
            const int m2 = (m + NGW < M) ? m + NGW : m;
            const f32x4* xr = (const f32x4*)(F_x + (size_t)m * DM) + lane; const f32x4* xr2 = (const f32x4*)(F_x + (size_t)m2 * DM) + lane;
            f32x4 v[8], v2[8]; float sa = 0.f, sb = 0.f;
#pragma unroll
            for (int j = 0; j < 8; ++j) { v[j] = xr[64 * j]; v2[j] = xr2[64 * j]; }
#pragma unroll
            for (int j = 0; j < 8; ++j) { sa += (v[j][0] * v[j][0] + v[j][1] * v[j][1]) + (v[j][2] * v[j][2] + v[j][3] * v[j][3]); sb += (v2[j][0] * v2[j][0] + v2[j][1] * v2[j][1]) + (v2[j][2] * v2[j][2] + v2[j][3] * v2[j][3]); }
            const float rs = __builtin_amdgcn_rsqf(wave_sum(sa) * (1.0f / DM) + EPS), rs2 = __builtin_amdgcn_rsqf(wave_sum(sb) * (1.0f / DM) + EPS);
            u32x2* o = (u32x2*)(F_HB + (size_t)m * DM) + lane; u32x2* o2 = (u32x2*)(F_HB + (size_t)m2 * DM) + lane;
#pragma unroll
            for (int j = 0; j < 8; ++j) { u32x2 w; w.x = cvt_pk_bf16(v[j][0] * rs * gv[j][0], v[j][1] * rs * gv[j][1]); w.y = cvt_pk_bf16(v[j][2] * rs * gv[j][2], v[j][3] * rs * gv[j][3]); o[64 * j] = w;
                u32x2 w2; w2.x = cvt_pk_bf16(v2[j][0] * rs2 * gv[j][0], v2[j][1] * rs2 * gv[j][1]); w2.y = cvt_pk_bf16(v2[j][2] * rs2 * gv[j][2], v2[j][3] * rs2 * gv[j][3]); o2[64 * j] = w2; }
        }
    }
    for (int i = gt; i < M * PLE / 4; i += NGT) { const f32x4 v = ((const f32x4*)F_p)[i]; u32x2 w; w.x = cvt_pk_bf16(v[0], v[1]); w.y = cvt_pk_bf16(v[2], v[3]); ((u32x2*)F_PBF)[i] = w; }
    for (int i = gt; i < 8 * 128 * 128 / 4; i += NGT) { const f32x4 v = ((const f32x4*)F_sgu_w)[i]; u32x2 w; w.x = cvt_pk_bf16(v[0], v[1]); w.y = cvt_pk_bf16(v[2], v[3]); ((u32x2*)F_SGUW)[i] = w; }
    for (int i = gt; i < 2048; i += NGT) { const float* l = (i < 1024) ? F_lbfl : F_lbbl; const int c = i & 1023; const float a = l[c], b = l[1024 + c], mx = fmaxf(a, b), ea = __expf(a - mx), eb = __expf(b - mx);
        F_ctl[(i < 1024 ? CT_LBF : CT_LBB) + c] = ea / (ea + eb); }
    for (int i = gt; i < 5 * M; i += NGT) F_ctl[CT_VSUM + i] = 0.f;
}

__device__ __forceinline__ bf16x8 ldfrag(const LAS unsigned char* base, int pitch, int row, int kbyte) { return *(const LAS bf16x8*)(base + row * pitch + kbyte); }
#define MFMA16(a, b, c) __builtin_amdgcn_mfma_f32_16x16x32_bf16((b), (a), (c), 0, 0, 0)

constexpr int P128 = 272, P64 = 144;
constexpr int H_QT = 0, H_KT = H_QT + 64 * P128, H_QTB = H_KT + 64 * P128, H_KTB = H_QTB + 64 * P128, H_SS = H_KTB + 64 * P128, H_VT = H_SS + 128 * P128, H_PB = H_VT + 128 * P64, H_TOT = H_PB + 64 * P64, H_RSX = H_TOT + 4096, H_KTH = H_RSX + 512, H_DLF = H_KTH + 128 * P64, H_END = H_DLF + 512;
constexpr int H_RAWF = 0, H_RAWB = 16384, H_RAWQ = 32768, H_RAWV = 49152;
static_assert(H_RAWV + 16384 <= H_SS && H_END <= LDS_BARST, "raw alias / lds");
static_assert(H_END <= LDS_BYTES, "lds");

__device__ __forceinline__ u32x4 pack8(const float* v) { u32x4 w; w.x = cvt_pk_bf16(v[0], v[1]); w.y = cvt_pk_bf16(v[2], v[3]); w.z = cvt_pk_bf16(v[4], v[5]); w.w = cvt_pk_bf16(v[6], v[7]); return w; }
__device__ __forceinline__ int invperm32(int kk) { return 16 * ((kk >> 2) & 1) + (((kk >> 3) << 2) | (kk & 3)); }
__device__ __forceinline__ unsigned short lds_u16(const LAS unsigned char* p) { return *(const LAS unsigned short*)p; }

constexpr int NSEGC = 16, NSEG = BATCH * NHEAD * (NCHUNK / NSEGC);
constexpr int T_KT = 0, T_DL = 4 * 128 * P64, T_END = T_DL + 2048;
static_assert(T_END <= LDS_BYTES, "s1 lds");
__device__ __forceinline__ void unpack_lf16(const u32x4 (&r)[2], float (&o)[16]) {
#pragma unroll
    for (int q = 0; q < 2; ++q)
#pragma unroll
        for (int e = 0; e < 4; ++e) { o[8 * q + 2 * e] = h2f((unsigned short)(r[q][e] & 0xffffu)) * 1.4426950408889634f; o[8 * q + 2 * e + 1] = h2f((unsigned short)(r[q][e] >> 16)) * 1.4426950408889634f; }
}
__device__ __forceinline__ void hgrn_s1(Frame& F) {
    LAS unsigned char* lds = F.lds;
    PHASE_IDS();
    const int k = tid >> 2, tq = tid & 3, w = wave, fr = lane & 15, fq = lane >> 4;
    const int kr = (k & ~31) + invperm32(k & 31);
    const int lq = lane & ~3;
    u32x4 rlf[2], rlb[2], raf[2], rab[2];
#define S1_LOAD(bh_, cf_, cb_) do { const bf16_t* tf_ = F_PROJ + (size_t)(((bh_) >> 3) * 256 + (cf_)) * PT_CHUNK + ((bh_) & 7) * PT_TILE; const bf16_t* tb_ = F_PROJ + (size_t)(((bh_) >> 3) * 256 + (cb_)) * PT_CHUNK + ((bh_) & 7) * PT_TILE; \
        rlf[0] = *(const u32x4*)(tf_ + 1 * PT_SEG + k * 64 + 16 * tq); rlf[1] = *(const u32x4*)(tf_ + 1 * PT_SEG + k * 64 + 16 * tq + 8); \
        rlb[0] = *(const u32x4*)(tb_ + 2 * PT_SEG + k * 64 + 16 * tq); rlb[1] = *(const u32x4*)(tb_ + 2 * PT_SEG + k * 64 + 16 * tq + 8); \
        raf[0] = *(const u32x4*)(tf_ + 3 * PT_SEG + (16 * w + fr) * 64 + 8 * fq); raf[1] = *(const u32x4*)(tf_ + 3 * PT_SEG + (16 * w + fr) * 64 + 32 + 8 * fq); \
        rab[0] = *(const u32x4*)(tb_ + 3 * PT_SEG + (16 * w + fr) * 64 + 8 * fq); rab[1] = *(const u32x4*)(tb_ + 3 * PT_SEG + (16 * w + fr) * 64 + 32 + 8 * fq); } while (0)
    for (int sg = F.bid; sg < NSEG; sg += F.G) {
        const int bh = sg >> 4, seg = sg & 15;
        f32x4 Rf[4][2], Rb[4][2];
#pragma unroll
        for (int gg = 0; gg < 4; ++gg)
#pragma unroll
            for (int n = 0; n < 2; ++n) { Rf[gg][n] = (f32x4){0.f, 0.f, 0.f, 0.f}; Rb[gg][n] = (f32x4){0.f, 0.f, 0.f, 0.f}; }
        float cumf = 0.f, cumb = 0.f;
        S1_LOAD(bh, NSEGC * seg, NSEGC * seg + NSEGC - 1);
#pragma unroll 1
        for (int i = 0; i < NSEGC; ++i) {
            const int cf = NSEGC * seg + i, cb = NSEGC * seg + NSEGC - 1 - i, par = i & 1;
            float lff[16], lfb[16];
            unpack_lf16(rlf, lff); unpack_lf16(rlb, lfb);
            const bf16x8 a0f = __builtin_bit_cast(bf16x8, raf[0]), a1f = __builtin_bit_cast(bf16x8, raf[1]), a0b = __builtin_bit_cast(bf16x8, rab[0]), a1b = __builtin_bit_cast(bf16x8, rab[1]);
#pragma unroll
            for (int dir = 1; dir < 2; ++dir) {
                bf16_t* Sd = F_S + (size_t)((bh * 2 + dir) * 256 + (dir ? cb : cf)) * 16384 + (size_t)(16 * w + fr) * 128 + 8 * fq;
#pragma unroll
                for (int gg = 0; gg < 4; ++gg) { const f32x4 r0 = dir ? Rb[gg][0] : Rf[gg][0], r1 = dir ? Rb[gg][1] : Rf[gg][1];
                    u32x4 o; o.x = cvt_pk_bf16(r0[0], r0[1]); o.y = cvt_pk_bf16(r0[2], r0[3]); o.z = cvt_pk_bf16(r1[0], r1[1]); o.w = cvt_pk_bf16(r1[2], r1[3]);
                    *(u32x4*)(Sd + 32 * gg) = o; }
            }
            if (i + 1 < NSEGC) S1_LOAD(bh, cf + 1, cb - 1);
            float tf = 0.f, tb = 0.f;
#pragma unroll
            for (int j = 0; j < 16; ++j) { tf += lff[j]; tb += lfb[j]; }
            float offF = 0.f, offB = 0.f, totf = 0.f, totb = 0.f;
#pragma unroll
            for (int q = 0; q < 4; ++q) { const float a = __shfl(tf, lq + q), bb = __shfl(tb, lq + q); totf += a; totb += bb; if (q > tq) offF += a; if (q < tq) offB += bb; }
            float kh[16];
            {
                float run = offF, ep = __builtin_amdgcn_exp2f(run);
#pragma unroll
                for (int j = 15; j >= 0; --j) { run += lff[j]; const float en = __builtin_amdgcn_exp2f(run); kh[j] = ep - en; ep = en; }
                LAS unsigned char* dst = lds + T_KT + (par * 2 + 0) * 128 * P64 + kr * P64 + tq * 32;
                *(LAS u32x4*)dst = pack8(kh); *(LAS u32x4*)(dst + 16) = pack8(kh + 8);
            }
            {
                float run = offB, ep = __builtin_amdgcn_exp2f(run);
#pragma unroll
                for (int j = 0; j < 16; ++j) { run += lfb[j]; const float en = __builtin_amdgcn_exp2f(run); kh[j] = ep - en; ep = en; }
                LAS unsigned char* dst = lds + T_KT + (par * 2 + 1) * 128 * P64 + kr * P64 + tq * 32;
                *(LAS u32x4*)dst = pack8(kh); *(LAS u32x4*)(dst + 16) = pack8(kh + 8);
            }
            LAS float* DL = (LAS float*)(lds + T_DL) + par * 256;
            if (tq == 0) { DL[k] = __builtin_amdgcn_exp2f(totf); }
            if (tq == 1) { F_DEC[(size_t)((bh * 2 + 1) * 256 + cb) * 128 + k] = __builtin_amdgcn_exp2f(cumb); DL[128 + k] = __builtin_amdgcn_exp2f(totb); }
            cumf += totf; cumb += totb;
            LBAR();
#pragma unroll
            for (int dir = 0; dir < 2; ++dir) {
                const LAS unsigned char* kt = lds + T_KT + (par * 2 + dir) * 128 * P64;
                const bf16x8 a0 = dir ? a0b : a0f, a1 = dir ? a1b : a1f;
#pragma unroll
                for (int gg = 0; gg < 4; ++gg) {
                    f32x4 r0 = dir ? Rb[gg][0] : Rf[gg][0], r1 = dir ? Rb[gg][1] : Rf[gg][1];
                    const f32x4 d0 = *(const LAS f32x4*)(DL + dir * 128 + 32 * gg + 8 * fq), d1 = *(const LAS f32x4*)(DL + dir * 128 + 32 * gg + 8 * fq + 4);
                    r0 = r0 * d0; r1 = r1 * d1;
                    r0 = MFMA16(a0, ldfrag(kt, P64, 32 * gg + fr, fq * 16), r0);
                    r1 = MFMA16(a0, ldfrag(kt, P64, 32 * gg + 16 + fr, fq * 16), r1);
                    r0 = MFMA16(a1, ldfrag(kt, P64, 32 * gg + fr, 64 + fq * 16), r0);
                    r1 = MFMA16(a1, ldfrag(kt, P64, 32 * gg + 16 + fr, 64 + fq * 16), r1);
                    if (dir) { Rb[gg][0] = r0; Rb[gg][1] = r1; } else { Rf[gg][0] = r0; Rf[gg][1] = r1; }
                }
            }
        }
#pragma unroll
        for (int dir = 0; dir < 2; ++dir) {
            bf16_t* Sd = F_SEG + (size_t)((bh * 2 + dir) * 16 + seg) * 16384 + (size_t)(16 * w + fr) * 128 + 8 * fq;
#pragma unroll
            for (int gg = 0; gg < 4; ++gg) { const f32x4 r0 = dir ? Rb[gg][0] : Rf[gg][0], r1 = dir ? Rb[gg][1] : Rf[gg][1];
                u32x4 o; o.x = cvt_pk_bf16(r0[0], r0[1]); o.y = cvt_pk_bf16(r0[2], r0[3]); o.z = cvt_pk_bf16(r1[0], r1[1]); o.w = cvt_pk_bf16(r1[2], r1[3]);
                *(u32x4*)(Sd + 32 * gg) = o; }
        }
        if (tq == 0) F_DSEG[(size_t)((bh * 2 + 0) * 16 + seg) * 128 + k] = __builtin_amdgcn_exp2f(cumf);
        if (tq == 1) F_DSEG[(size_t)((bh * 2 + 1) * 16 + seg) * 128 + k] = __builtin_amdgcn_exp2f(cumb);
        LBAR();
    }
#undef S1_LOAD
}

__device__ __forceinline__ void hgrn_s2(Frame& F) {
    PHASE_IDS();
    for (int e = F.bid * 512 + tid; e < 32 * 4096; e += F.G * 512) {
        const int stream = e >> 12, off = (e & 4095) * 4, dir = stream & 1;
        const bf16_t* Sg = F_SEG + (size_t)stream * 16 * 16384 + off; bf16_t* Cg = F_CARRY + (size_t)stream * 16 * 16384 + off; const float* Dg = F_DSEG + (size_t)stream * 16 * 128 + (off & 127);
        u32x2 loc[16]; f32x4 dd[16];
#pragma unroll
        for (int u = 0; u < 16; ++u) { const int sx = dir ? 15 - u : u; loc[u] = *(const u32x2*)(Sg + (size_t)sx * 16384); dd[u] = *(const f32x4*)(Dg + (size_t)sx * 128); }
        f32x4 run = {0.f, 0.f, 0.f, 0.f};
#pragma unroll
        for (int u = 0; u < 16; ++u) { const int sx = dir ? 15 - u : u;
            u32x2 o; o.x = cvt_pk_bf16(run[0], run[1]); o.y = cvt_pk_bf16(run[2], run[3]); *(u32x2*)(Cg + (size_t)sx * 16384) = o;
            run[0] = dd[u][0] * run[0] + bflo(loc[u].x); run[1] = dd[u][1] * run[1] + bfhi(loc[u].x); run[2] = dd[u][2] * run[2] + bflo(loc[u].y); run[3] = dd[u][3] * run[3] + bfhi(loc[u].y); }
    }
}

__device__ __forceinline__ u32x4 comb8(u32x4 sp, u32x4 cr, f32x4 d0, f32x4 d1) {
    u32x4 o;
    o.x = cvt_pk_bf16(bflo(sp.x) + d0[0] * bflo(cr.x), bfhi(sp.x) + d0[1] * bfhi(cr.x)); o.y = cvt_pk_bf16(bflo(sp.y) + d0[2] * bflo(cr.y), bfhi(sp.y) + d0[3] * bfhi(cr.y));
    o.z = cvt_pk_bf16(bflo(sp.z) + d1[0] * bflo(cr.z), bfhi(sp.z) + d1[1] * bfhi(cr.z)); o.w = cvt_pk_bf16(bflo(sp.w) + d1[2] * bflo(cr.w), bfhi(sp.w) + d1[3] * bfhi(cr.w));
    return o;
}
__device__ __forceinline__ void hgrn_s3(Frame& F) {
    LAS unsigned char* lds = F.lds;
    PHASE_IDS();
    const int k = tid >> 2, tq = tid & 3, w = wave, fr = lane & 15, fq = lane >> 4;
    const int tb = w & 3, half = w >> 2, lq = lane & ~3;
    LAS float* RSX = (LAS float*)(lds + H_RSX);
    const int NL = F.bid < NSEG ? ((NSEG - F.bid + F.G - 1) / F.G) * NSEGC : 0;
    u32x4 rq[2], rlf[2], rlb[2], rv[2], rsb[4], rcb[4]; f32x4 dcb[2];
    f32x4 Rf[4][2];
    const int kr = (k & ~31) + invperm32(k & 31), rrw = ((16 * w + fr) & ~31) + invperm32((16 * w + fr) & 31);
#define S3_DEC(L_, c_, bh_) const int sg_ = F.bid + ((L_) >> 4) * F.G; const int bh_ = sg_ >> 4, c_ = NSEGC * (sg_ & 15) + ((L_) & 15)
    const int pc8 = tid & 15;
#define S3_LOAD(it) do { S3_DEC(it, c_, bh_); const bf16_t* bp_ = F_PROJ + (size_t)((bh_ >> 3) * 256 + c_) * PT_CHUNK + (bh_ & 7) * PT_TILE; \
        _Pragma("unroll") for (int i_ = 0; i_ < 2; ++i_) { rq[i_] = *(const u32x4*)(bp_ + 0 * PT_SEG + k * 64 + 16 * tq + 8 * i_); rlf[i_] = *(const u32x4*)(bp_ + 1 * PT_SEG + k * 64 + 16 * tq + 8 * i_); rlb[i_] = *(const u32x4*)(bp_ + 2 * PT_SEG + k * 64 + 16 * tq + 8 * i_); \
            rv[i_] = *(const u32x4*)(bp_ + 3 * PT_SEG + (tid + 512 * i_) * 8); } } while (0)
#define S3_LOADS(it) do { S3_DEC(it, c_, bh_); const bf16_t* sb_ = F_S + (size_t)((bh_ * 2 + 1) * 256 + c_) * 16384 + tid * 8; \
        _Pragma("unroll") for (int i_ = 0; i_ < 4; ++i_) { rsb[i_] = *(const u32x4*)(sb_ + i_ * 4096); } \
        const float* db_ = F_DEC + (size_t)((bh_ * 2 + 1) * 256 + c_) * 128 + pc8 * 8; \
        dcb[0] = *(const f32x4*)db_; dcb[1] = *(const f32x4*)(db_ + 4); \
        if ((((it) & 15) == 0)) { const bf16_t* cb_ = F_CARRY + (size_t)((bh_ * 2 + 1) * 16 + (c_ >> 4)) * 16384 + tid * 8; \
            _Pragma("unroll") for (int i_ = 0; i_ < 4; ++i_) { rcb[i_] = *(const u32x4*)(cb_ + i_ * 4096); } } } while (0)
    if (NL > 0) { S3_LOAD(0); S3_LOADS(0); }
    f32x4 ogv[2][2];
#pragma unroll
    for (int i = 0; i < 2; ++i) { ogv[i][0] = *(const f32x4*)(F_onorm_g + 64 * half + 32 * i + 8 * fq); ogv[i][1] = *(const f32x4*)(F_onorm_g + 64 * half + 32 * i + 8 * fq + 4); }
    u32x4 po[2]; bf16_t* pop = nullptr;
#pragma unroll 1
    for (int L = 0; L < NL; ++L) {
        S3_DEC(L, c, bh); const int h = bh & 7, b = bh >> 3;
        const size_t row0 = (size_t)b * SEQ + 64 * c;
        const bool has_next = L + 1 < NL;
        if (L > 0) { *(u32x4*)pop = po[0]; *(u32x4*)(pop + 32) = po[1]; }
        if ((L & 15) == 0) {
            const bf16_t* cp = F_CARRY + (size_t)((bh * 2 + 0) * 16 + (c >> 4)) * 16384 + (size_t)(16 * w + fr) * 128 + 8 * fq;
#pragma unroll
            for (int gg = 0; gg < 4; ++gg) { const u32x4 cw = *(const u32x4*)(cp + 32 * gg); Rf[gg][0] = (f32x4){bflo(cw.x), bfhi(cw.x), bflo(cw.y), bfhi(cw.y)}; Rf[gg][1] = (f32x4){bflo(cw.z), bfhi(cw.z), bflo(cw.w), bfhi(cw.w)}; }
        }
        float lff[16], lfb[16], qv[16];
        unpack_lf16(rlf, lff); unpack_lf16(rlb, lfb);
#pragma unroll
        for (int q = 0; q < 2; ++q)
#pragma unroll
            for (int e = 0; e < 4; ++e) { qv[8 * q + 2 * e] = bflo(rq[q][e]); qv[8 * q + 2 * e + 1] = bfhi(rq[q][e]); }
#pragma unroll
        for (int i = 0; i < 2; ++i) { const int p = tid + 512 * i, d = p >> 3, c8 = p & 7, dr_ = (d & ~31) + invperm32(d & 31); *(LAS u32x4*)(lds + H_VT + dr_ * P64 + c8 * 16) = rv[i]; }
        if (has_next) S3_LOAD(L + 1);
        float offF = 0.f, offB = 0.f, offFs = 0.f, totf = 0.f;
        {
            float tf = 0.f, tbw = 0.f;
#pragma unroll
            for (int j = 0; j < 16; ++j) { tf += lff[j]; tbw += lfb[j]; }
#pragma unroll
            for (int q = 0; q < 4; ++q) { const float a_ = __shfl(tf, lq + q), b_ = __shfl(tbw, lq + q); totf += a_; if (q < tq) offF += a_; if (q > tq) { offB += b_; offFs += a_; } }
        }
        {
            float kh[16]; float run = offFs, ep = __builtin_amdgcn_exp2f(run);
#pragma unroll
            for (int j = 15; j >= 0; --j) { run += lff[j]; const float en = __builtin_amdgcn_exp2f(run); kh[j] = ep - en; ep = en; }
            LAS unsigned char* dst = lds + H_KTH + kr * P64 + tq * 32;
            *(LAS u32x4*)dst = pack8(kh); *(LAS u32x4*)(dst + 16) = pack8(kh + 8);
            if (tq == 0) ((LAS float*)(lds + H_DLF))[k] = __builtin_amdgcn_exp2f(totf);
#pragma unroll
            for (int gg = 0; gg < 4; ++gg) { const f32x4 r0 = Rf[gg][0], r1 = Rf[gg][1];
                u32x4 o; o.x = cvt_pk_bf16(r0[0], r0[1]); o.y = cvt_pk_bf16(r0[2], r0[3]); o.z = cvt_pk_bf16(r1[0], r1[1]); o.w = cvt_pk_bf16(r1[2], r1[3]);
                *(LAS u32x4*)(lds + H_SS + rrw * P128 + (32 * gg + 8 * fq) * 2) = o; }
        }
        {
            float run = offF, rp = __builtin_amdgcn_exp2f(-run);
            float runb = offB, rpb = __builtin_amdgcn_exp2f(-runb);
#pragma unroll
            for (int j = 0; j < 16; ++j) { run += lff[j]; const int t = 16 * tq + j; const float rn = __builtin_amdgcn_exp2f(-run);
                *(LAS bf16_t*)(lds + H_QT + t * P128 + k * 2) = (bf16_t)(cvt_pk_bf16(qv[j] * __builtin_amdgcn_exp2f(run), 0.f) & 0xffff);
                *(LAS bf16_t*)(lds + H_KT + t * P128 + k * 2) = (bf16_t)(cvt_pk_bf16(rn - rp, 0.f) & 0xffff); rp = rn;
                const int jb = 15 - j, tb_ = 16 * tq + jb; runb += lfb[jb]; const float rnb = __builtin_amdgcn_exp2f(-runb);
                *(LAS bf16_t*)(lds + H_QTB + tb_ * P128 + k * 2) = (bf16_t)(cvt_pk_bf16(qv[jb] * __builtin_amdgcn_exp2f(runb), 0.f) & 0xffff);
                *(LAS bf16_t*)(lds + H_KTB + tb_ * P128 + k * 2) = (bf16_t)(cvt_pk_bf16(rnb - rpb, 0.f) & 0xffff); rpb = rnb; }
        }
        LBAR();
        f32x4 oacc[4];
#pragma unroll
        for (int i = 0; i < 4; ++i) oacc[i] = (f32x4){0.f, 0.f, 0.f, 0.f};
        {
            f32x4 pf[2], pb[2];
#pragma unroll
            for (int i = 0; i < 2; ++i) { pf[i] = (f32x4){0.f, 0.f, 0.f, 0.f}; pb[i] = (f32x4){0.f, 0.f, 0.f, 0.f}; }
#pragma unroll
            for (int ks = 0; ks < 4; ++ks) {
                const bf16x8 a = ldfrag(lds + H_QT, P128, 16 * tb + fr, ks * 64 + fq * 16), ab = ldfrag(lds + H_QTB, P128, 16 * tb + fr, ks * 64 + fq * 16);
#pragma unroll
                for (int i = 0; i < 2; ++i) { pf[i] = MFMA16(a, ldfrag(lds + H_KT, P128, 16 * (2 * half + i) + fr, ks * 64 + fq * 16), pf[i]); pb[i] = MFMA16(ab, ldfrag(lds + H_KTB, P128, 16 * (2 * half + i) + fr, ks * 64 + fq * 16), pb[i]); }
#pragma unroll
                for (int i = 0; i < 4; ++i) oacc[i] = MFMA16(a, ldfrag(lds + H_SS, P128, 16 * (4 * half + i) + fr, ks * 64 + fq * 16), oacc[i]);
            }
            const int t = 16 * tb + fr;
#pragma unroll
            for (int i = 0; i < 2; ++i) { const int s0 = 16 * (2 * half + i) + 4 * fq; float pv[4];
#pragma unroll
                for (int j = 0; j < 4; ++j) { const int s_ = s0 + j; pv[j] = (s_ <= t ? pf[i][j] : 0.f) + (s_ >= t ? pb[i][j] : 0.f); }
                u32x2 o; o.x = cvt_pk_bf16(pv[0], pv[1]); o.y = cvt_pk_bf16(pv[2], pv[3]);
                *(LAS u32x2*)(lds + H_PB + t * P64 + s0 * 2) = o; }
        }
        {
            const bf16x8 a0 = ldfrag(lds + H_VT, P64, rrw, fq * 16), a1 = ldfrag(lds + H_VT, P64, rrw, 64 + fq * 16);
            const LAS float* DLF = (const LAS float*)(lds + H_DLF);
#pragma unroll
            for (int gg = 0; gg < 4; ++gg) {
                f32x4 r0 = Rf[gg][0], r1 = Rf[gg][1];
                const f32x4 d0 = *(const LAS f32x4*)(DLF + 32 * gg + 8 * fq), d1 = *(const LAS f32x4*)(DLF + 32 * gg + 8 * fq + 4);
                r0 = r0 * d0; r1 = r1 * d1;
                r0 = MFMA16(a0, ldfrag(lds + H_KTH, P64, 32 * gg + fr, fq * 16), r0);
                r1 = MFMA16(a0, ldfrag(lds + H_KTH, P64, 32 * gg + 16 + fr, fq * 16), r1);
                r0 = MFMA16(a1, ldfrag(lds + H_KTH, P64, 32 * gg + fr, 64 + fq * 16), r0);
                r1 = MFMA16(a1, ldfrag(lds + H_KTH, P64, 32 * gg + 16 + fr, 64 + fq * 16), r1);
                Rf[gg][0] = r0; Rf[gg][1] = r1;
            }
        }
        LBAR();
        u32x4 gw[2];
        {
#pragma unroll
            for (int i = 0; i < 4; ++i) { const int p = tid + 512 * i, r = p >> 4, cc = p & 15, rr = (r & ~31) + invperm32(r & 31); *(LAS u32x4*)(lds + H_SS + rr * P128 + cc * 16) = comb8(rsb[i], rcb[i], dcb[0], dcb[1]); }
            if (has_next) S3_LOADS(L + 1);
            const bf16_t* gp = F_PROJ + (size_t)(b * 256 + c) * PT_CHUNK + 4 * PT_SEG + h * PT_TILE + (16 * tb + fr) * 128 + 64 * half + 8 * fq;
#pragma unroll
            for (int i = 0; i < 2; ++i) gw[i] = *(const u32x4*)(gp + 32 * i);
        }
        LBAR();
#pragma unroll
        for (int ks = 0; ks < 4; ++ks) {
            const bf16x8 ab = ldfrag(lds + H_QTB, P128, 16 * tb + fr, ks * 64 + fq * 16);
#pragma unroll
            for (int i = 0; i < 4; ++i) oacc[i] = MFMA16(ab, ldfrag(lds + H_SS, P128, 16 * (4 * half + i) + fr, ks * 64 + fq * 16), oacc[i]);
        }
#pragma unroll
        for (int ks = 0; ks < 2; ++ks) {
            const bf16x8 a = ldfrag(lds + H_PB, P64, 16 * tb + fr, ks * 64 + fq * 16);
#pragma unroll
            for (int i = 0; i < 4; ++i) oacc[i] = MFMA16(a, ldfrag(lds + H_VT, P64, 16 * (4 * half + i) + fr, ks * 64 + fq * 16), oacc[i]);
        }
        {
            const int t = 16 * tb + fr;
            float ss = 0.f;
#pragma unroll
            for (int i = 0; i < 4; ++i) ss += (oacc[i][0] * oacc[i][0] + oacc[i][1] * oacc[i][1]) + (oacc[i][2] * oacc[i][2] + oacc[i][3] * oacc[i][3]);
            ss += __shfl_xor(ss, 16); ss += __shfl_xor(ss, 32);
            if (fq == 0) RSX[half * 64 + t] = ss;
            LBAR();
            const float rs = __builtin_amdgcn_rsqf((RSX[t] + RSX[64 + t]) * (1.0f / 128.0f) + EPS);
            bf16_t* op = F_CAT + (row0 + t) * DM + h * 128;
#pragma unroll
            for (int i = 0; i < 2; ++i) { const int d = 64 * half + 32 * i + 8 * fq;
                const f32x4 og0 = ogv[i][0], og1 = ogv[i][1]; (void)d;
                const f32x4 e0 = oacc[2 * i], e1 = oacc[2 * i + 1];
                u32x4 o; o.x = cvt_pk_bf16(e0[0] * rs * og0[0] * bflo(gw[i].x), e0[1] * rs * og0[1] * bfhi(gw[i].x));
                o.y = cvt_pk_bf16(e0[2] * rs * og0[2] * bflo(gw[i].y), e0[3] * rs * og0[3] * bfhi(gw[i].y));
                o.z = cvt_pk_bf16(e1[0] * rs * og1[0] * bflo(gw[i].z), e1[1] * rs * og1[1] * bfhi(gw[i].z));
                o.w = cvt_pk_bf16(e1[2] * rs * og1[2] * bflo(gw[i].w), e1[3] * rs * og1[3] * bfhi(gw[i].w));
                po[i] = o; }
            pop = op + 64 * half + 8 * fq;
        }
    }
    if (NL > 0) { *(u32x4*)pop = po[0]; *(u32x4*)(pop + 32) = po[1]; }
#undef S3_LOAD
#undef S3_LOADS
#undef S3_DEC
}

constexpr int G_RAW = 0, G_WL = 32768, G_VT = G_WL + 2 * 128 * P128, G_STAT = G_VT + 128 * P128;
static_assert(G_STAT + 1024 <= LDS_BYTES, "sgu lds");
__device__ __forceinline__ void sgu_phase(Frame& F) {
    LAS unsigned char* lds = F.lds;
    PHASE_IDS();
    const int d_e = tid & 127, sq = tid >> 7, w = wave, fr = lane & 15, fq = lane >> 4;
    LAS f32x2* STAT = (LAS f32x2*)(lds + G_STAT);
    const int dr = (d_e & ~31) + invperm32(d_e & 31);
    const float* vsum = F_ctl + CT_VSUM; const float* vssq = F_ctl + CT_VSSQ;
    u32x4 rvp[4], rw[4], uwn[4]; float lgn, lbn, bsn;
#define SGU_LOAD(r0_, g_) do { const bf16_t* vp_ = F_PROJ + (size_t)((r0_) >> 6) * PT_CHUNK + 6 * PT_SEG + (g_) * PT_TILE + (tid >> 4) * 128 + (tid & 15) * 8; const bf16_t* wp_ = F_SGUW + (size_t)(g_) * 16384 + tid * 8; \
        _Pragma("unroll") for (int i_ = 0; i_ < 4; ++i_) { rvp[i_] = *(const u32x4*)(vp_ + (size_t)(i_ >> 1) * PT_CHUNK + (i_ & 1) * 32 * 128); rw[i_] = *(const u32x4*)(wp_ + i_ * 4096); } \
        lgn = F_ln_g[(g_) * 128 + d_e]; lbn = F_ln_b[(g_) * 128 + d_e]; bsn = F_sgu_b[(g_) * 128 + 16 * w + fr]; \
        const bf16_t* up_ = F_PROJ + (size_t)(((r0_) >> 6) + (w >> 2)) * PT_CHUNK + 5 * PT_SEG + (g_) * PT_TILE + (16 * (w & 3) + fr) * 128 + 8 * fq; \
        _Pragma("unroll") for (int i_ = 0; i_ < 4; ++i_) uwn[i_] = *(const u32x4*)(up_ + 32 * i_); } while (0)
    for (int item = F.bid; item < M / 128; item += F.G) {
        const size_t r0 = (size_t)item * 128;
        SGU_LOAD(r0, 0);
        if (tid < 128) { const float mu = vsum[r0 + tid] * (1.0f / 1024.0f); const float var = vssq[r0 + tid] * (1.0f / 1024.0f) - mu * mu; STAT[tid] = (f32x2){mu, __builtin_amdgcn_rsqf(fmaxf(var, 0.f) + EPS)}; }
        const int t = 16 * w + fr;
        float ssq = 0.f;
#pragma unroll 1
        for (int g = 0; g < 8; ++g) {
            const int wl = G_WL + (g & 1) * 128 * P128;
            const float lg = lgn, lb = lbn, bs = bsn; u32x4 uw[4];
#pragma unroll
            for (int i = 0; i < 4; ++i) uw[i] = uwn[i];
#pragma unroll
            for (int i = 0; i < 4; ++i) { const int p = tid + 512 * i, r = p >> 4, cc = p & 15;
                *(LAS u32x4*)(lds + G_RAW + r * 256 + cc * 16) = rvp[i]; *(LAS u32x4*)(lds + wl + r * P128 + cc * 16) = rw[i]; }
            if (g < 7) SGU_LOAD(r0, g + 1);
            LBAR();
            {
#pragma unroll
                for (int i = 0; i < 4; ++i) { float y[8];
#pragma unroll
                    for (int j = 0; j < 8; ++j) { const int s_ = 32 * sq + 8 * i + j; const f32x2 st = STAT[s_]; y[j] = (bf2f(lds_u16(lds + G_RAW + s_ * 256 + d_e * 2)) - st[0]) * st[1] * lg + lb; }
                    *(LAS u32x4*)(lds + G_VT + dr * P128 + (32 * sq + 8 * i) * 2) = pack8(y); }
            }
            LBAR();
            bf16x8 a[4];
#pragma unroll
            for (int ks = 0; ks < 4; ++ks) a[ks] = ldfrag(lds + wl, P128, 16 * w + fr, ks * 64 + fq * 16);
            bf16_t* op = F_CAT + (r0 + t) * DM + 1024 + g * 128 + 8 * fq;
#pragma unroll
            for (int gg = 0; gg < 4; ++gg) {
                f32x4 acc0 = {0.f, 0.f, 0.f, 0.f}, acc1 = {0.f, 0.f, 0.f, 0.f};
#pragma unroll
                for (int ks = 0; ks < 4; ++ks) { acc0 = MFMA16(a[ks], ldfrag(lds + G_VT, P128, 32 * gg + fr, ks * 64 + fq * 16), acc0); acc1 = MFMA16(a[ks], ldfrag(lds + G_VT, P128, 32 * gg + 16 + fr, ks * 64 + fq * 16), acc1); }
                const u32x4 uq = uw[gg];
                const float v0 = bflo(uq.x) * (acc0[0] + bs), v1 = bfhi(uq.x) * (acc0[1] + bs), v2 = bflo(uq.y) * (acc0[2] + bs), v3 = bfhi(uq.y) * (acc0[3] + bs);
                const float v4 = bflo(uq.z) * (acc1[0] + bs), v5 = bfhi(uq.z) * (acc1[1] + bs), v6 = bflo(uq.w) * (acc1[2] + bs), v7 = bfhi(uq.w) * (acc1[3] + bs);
                ssq += (v0 * v0 + v1 * v1) + (v2 * v2 + v3 * v3) + (v4 * v4 + v5 * v5) + (v6 * v6 + v7 * v7);
                u32x4 o; o.x = cvt_pk_bf16(v0, v1); o.y = cvt_pk_bf16(v2, v3); o.z = cvt_pk_bf16(v4, v5); o.w = cvt_pk_bf16(v6, v7);
                *(u32x4*)(op + 32 * gg) = o;
            }
        }
        ssq += __shfl_xor(ssq, 16); ssq += __shfl_xor(ssq, 32);
        const float rs = __builtin_amdgcn_rsqf(ssq * (1.0f / 1024.0f) + EPS);
        asm volatile("s_waitcnt vmcnt(0)" ::: "memory");
#pragma unroll 1
        for (int gh = 0; gh < 2; ++gh) {
            bf16_t* op = F_CAT + (r0 + t) * DM + 1024 + gh * 512 + 8 * fq; const float* og = F_sgu_onorm + gh * 512 + 8 * fq;
            u32x4 vw[16];
#pragma unroll
            for (int q = 0; q < 16; ++q) vw[q] = *(const u32x4*)(op + 32 * q);
#pragma unroll
            for (int q = 0; q < 16; ++q) { const f32x4 o4 = *(const f32x4*)(og + 32 * q), o5 = *(const f32x4*)(og + 32 * q + 4);
                u32x4 o; o.x = cvt_pk_bf16(bflo(vw[q].x) * rs * o4[0], bfhi(vw[q].x) * rs * o4[1]); o.y = cvt_pk_bf16(bflo(vw[q].y) * rs * o4[2], bfhi(vw[q].y) * rs * o4[3]);
                o.z = cvt_pk_bf16(bflo(vw[q].z) * rs * o5[0], bfhi(vw[q].z) * rs * o5[1]); o.w = cvt_pk_bf16(bflo(vw[q].w) * rs * o5[2], bfhi(vw[q].w) * rs * o5[3]);
                *(u32x4*)(op + 32 * q) = o; }
        }
        LBAR();
    }
#undef SGU_LOAD
}

__device__ __forceinline__ void final_norm(Frame& F) {
    PHASE_IDS();
    const int gw = F.bid * 8 + wave, NGW = F.G * 8;
    const float* ssq = F_ctl + CT_SSQ3;
    f32x4 gv[8];
#pragma unroll
    for (int j = 0; j < 8; ++j) gv[j] = *((const f32x4*)F_final_g + lane + 64 * j);
    for (int m = gw; m < M; m += 2 * NGW) {
        const int m2 = (m + NGW < M) ? m + NGW : m;
        const float rs = __builtin_amdgcn_rsqf(ssq[m] * (1.0f / DM) + EPS), rs2 = __builtin_amdgcn_rsqf(ssq[m2] * (1.0f / DM) + EPS);
        const u32x2* hr = (const u32x2*)(F_H3B + (size_t)m * DM) + lane; const u32x2* hr2 = (const u32x2*)(F_H3B + (size_t)m2 * DM) + lane;
        f32x4* xr = (f32x4*)(F.out + (size_t)m * DM) + lane; f32x4* xr2 = (f32x4*)(F.out + (size_t)m2 * DM) + lane;
        u32x2 hv[8], hv2[8];
#pragma unroll
        for (int j = 0; j < 8; ++j) { hv[j] = hr[64 * j]; hv2[j] = hr2[64 * j]; }
#pragma unroll
        for (int j = 0; j < 8; ++j) { f32x4 v = {bflo(hv[j].x), bfhi(hv[j].x), bflo(hv[j].y), bfhi(hv[j].y)}; v = v * rs * gv[j]; xr[64 * j] = v;
            f32x4 v2 = {bflo(hv2[j].x), bfhi(hv2[j].x), bflo(hv2[j].y), bfhi(hv2[j].y)}; v2 = v2 * rs2 * gv[j]; xr2[64 * j] = v2; }
    }
}

#define XB_TMO      128
#define XB_XCNT(j)  (256  + 64 * (j))
#define XB_XSUB(j)  (1280 + 64 * (j))
#define XB_XGEN(j)  (2304 + 64 * (j))
#define XB_TOP      3328
#define XB_TOPGEN   3392
#define XCD_BAR_WORDS 3456
#define XB_SPIN_CAP (1u << 18)

__device__ __forceinline__ unsigned xb_ld(unsigned* p)              { return __hip_atomic_load(p, __ATOMIC_RELAXED, __HIP_MEMORY_SCOPE_AGENT); }
__device__ __forceinline__ unsigned xb_add(unsigned* p, unsigned v) { return __hip_atomic_fetch_add(p, v, __ATOMIC_RELAXED, __HIP_MEMORY_SCOPE_AGENT); }
__device__ __forceinline__ unsigned xb_xcc_id() { return (unsigned)__builtin_amdgcn_s_getreg((3 << 11) | 20) & 0xFu; }
#define XB_SPIN(cond, bar) do { unsigned _sp = 0; while (cond) { __builtin_amdgcn_s_sleep(1); \
    if ((++_sp & 255u) == 0u) { if (xb_ld(&(bar)[XB_TMO])) break; if (_sp > XB_SPIN_CAP) { atomicAdd(&(bar)[XB_TMO], 1u); break; } } } } while (0)

struct XcdBarrier {
    unsigned* bar; unsigned x;
    volatile LAS unsigned* st;
};

__device__ __forceinline__ XcdBarrier xcd_barrier_post(unsigned* bar, volatile LAS unsigned* st) {
    XcdBarrier b; b.bar = bar; b.x = xb_xcc_id(); b.st = st;
    if (threadIdx.x == 0) (void)xb_add(&bar[XB_XCNT(b.x)], 1u);
    return b;
}
__device__ __forceinline__ void xcd_barrier_complete(unsigned* bar, unsigned x, unsigned& nloc, unsigned& nx) {
    const unsigned G = gridDim.x * gridDim.y * gridDim.z;
    unsigned sum, cnt, mine, sp = 0u;
    for (;;) {
        sum = 0u; cnt = 0u; mine = 0u;
#pragma unroll
        for (unsigned j = 0; j < 16; ++j) { const unsigned c = xb_ld(&bar[XB_XCNT(j)]); sum += c; cnt += (c > 0u) ? 1u : 0u; mine = (j == x) ? c : mine; }
        if (sum == G) break;
        __builtin_amdgcn_s_sleep(1);
        if ((++sp & 255u) == 0u) { if (xb_ld(&bar[XB_TMO])) break; if (sp > XB_SPIN_CAP) { atomicAdd(&bar[XB_TMO], 1u); break; } }
    }
    nloc = mine > 0u ? mine : 1u; nx = cnt > 0u ? cnt : 1u;
}

__device__ __forceinline__ void xcd_barrier(const XcdBarrier& b) {
    asm volatile("s_waitcnt vmcnt(0)" ::: "memory");
    __syncthreads();
    if (threadIdx.x == 0) {
        unsigned* bar = b.bar;
        __builtin_amdgcn_s_waitcnt(0);
        unsigned nloc = b.st[0], nx = b.st[1];
        if (nloc == 0u) { xcd_barrier_complete(bar, b.x, nloc, nx); b.st[0] = nloc; b.st[1] = nx; }
        const unsigned old = xb_add(&bar[XB_XSUB(b.x)], 1u);
        const unsigned gen = old / nloc;
        if (old + 1u == (gen + 1u) * nloc) {
            __builtin_amdgcn_fence(__ATOMIC_RELEASE, "agent");
            asm volatile("s_waitcnt vmcnt(0)" ::: "memory");
            const unsigned og = xb_add(&bar[XB_TOP], 1u);
            const unsigned tg = og / nx;
            if (og + 1u == (tg + 1u) * nx) xb_add(&bar[XB_TOPGEN], 1u);
            else XB_SPIN(xb_ld(&bar[XB_TOPGEN]) == tg, bar);
            __builtin_amdgcn_fence(__ATOMIC_ACQUIRE, "agent");
            xb_add(&bar[XB_XGEN(b.x)], 1u);
            asm volatile("s_waitcnt vmcnt(0)" ::: "memory");
        } else {
            XB_SPIN(xb_ld(&bar[XB_XGEN(b.x)]) == gen, bar);
            __builtin_amdgcn_fence(__ATOMIC_ACQUIRE, "agent");
            asm volatile("s_waitcnt vmcnt(0)" ::: "memory");
        }
    }
    __syncthreads();
}


constexpr int N_PHASES = 10;
__global__ void __launch_bounds__(512) mk_fwd(Args args) {
    extern __shared__ __attribute__((aligned(16))) unsigned char lds_raw[];
    Frame F;
    F.lds = (LAS unsigned char*)lds_raw;
    F.G = gridDim.x; F.bid = blockIdx.x;
    F.in = args.in; F.out = args.out; F.ws = args.ws;
    cg::grid_group grid = cg::this_grid();
    volatile LAS unsigned* bst = (volatile LAS unsigned*)(F.lds + LDS_BARST);
    if (threadIdx.x < 2) bst[threadIdx.x] = 0u;
    __syncthreads();
    const XcdBarrier bar = xcd_barrier_post((unsigned*)(args.ws + WS_BAR), bst);
    const int lo = args.ph_lo, hi = args.ph_hi;
#define IN(k) (lo <= (k) && (k) < hi)
#define SEAM(k) do { if (IN(k) && IN((k) + 1)) xcd_barrier(bar); } while (0)
    if (lo < 0) grid.sync();

    if (IN(0)) { p0_prologue(F); }
    SEAM(0);
    if (IN(1)) {
        { pg8::Gemm g{F_WIN, F_HB, 4096, M, DM}; pg8::StaticOrder S; S.init(4096, M, F.G, F.bid);
          EpiInT E{F_PROJ, F_ctl + CT_LBF, F_ctl + CT_LBB};
          pg8::gemm_phase<EpiInT, pg8::StaticOrder>(F.lds, g, S, E); }
        { pg8::Gemm g{F_HB, F_WIN + (size_t)4096 * DM, M, INC - 4096, DM}; pg8::StaticOrder S; S.init(M, INC - 4096, F.G, F.bid);
          EpiIn E{F_PROJ, F_ctl + CT_LBF, F_ctl + CT_LBB, F_ctl + CT_VSUM, F_ctl + CT_VSSQ, 4};
          pg8::gemm_phase<EpiIn, pg8::StaticOrder>(F.lds, g, S, E); }
    }
    SEAM(1);
    if (IN(2)) { hgrn_s1(F); __syncthreads(); sgu_phase(F); }
    SEAM(2);
    if (IN(3)) { hgrn_s2(F); }
    SEAM(3);
    if (IN(4)) { hgrn_s3(F); }
    SEAM(4);
    if (IN(5)) {
        pg8::Gemm g{F_CAT, F_WOUT, M, DM, DM}; pg8::StaticOrder S; S.init(M, DM, F.G, F.bid);
        EpiRes<false> E{F_x, F_HB, F_ctl + CT_SSQ1};
        pg8::gemm_phase<EpiRes<false>, pg8::StaticOrder>(F.lds, g, S, E);
    }
    SEAM(5);
    if (IN(6)) {
        { pg8::Gemm g{F_HB, F_WGU, M, 2 * FF, DM}; pg8::StaticOrder S; S.init(M, 2 * FF, F.G, F.bid);
          EpiGU E{F_ACT, F_ctl + CT_SSQ1};
          pg8::gemm_phase<EpiGU, pg8::StaticOrder>(F.lds, g, S, E); }
        { pg8::Gemm g{F_PBF, F_WPP, M, DM, PLE}; pg8::StaticOrder S; S.init(M, DM, F.G, F.bid);
          EpiPP E{F_PP};
          pg8::gemm_phase<EpiPP, pg8::StaticOrder>(F.lds, g, S, E); }
    }
    SEAM(6);
    if (IN(7)) {
        pg8::Gemm g{F_ACT, F_WDN, M, DM, FF}; pg8::StaticOrder S; S.init(M, DM, F.G, F.bid);
        EpiRes<true> E{nullptr, F_HB, F_ctl + CT_SSQ2};
        pg8::gemm_phase<EpiRes<true>, pg8::StaticOrder>(F.lds, g, S, E);
    }
    SEAM(7);
    if (IN(8)) {
        pg8::Gemm g{F_HB, F_WPG, M, DM, DM}; pg8::StaticOrder S; S.init(M, DM, F.G, F.bid);
        EpiPle E{F_HB, F_H3B, F_PP, F_ctl + CT_SSQ2, F_ctl + CT_SSQ3};
        pg8::gemm_phase<EpiPle, pg8::StaticOrder>(F.lds, g, S, E);
    }
    SEAM(8);
    if (IN(9)) { final_norm(F); }
#undef IN
#undef SEAM
}

extern "C" void kernel_launch(void* const* d_in, const int* in_sizes, int n_in, void* d_out, int out_size, void* d_ws, size_t ws_size, hipStream_t stream) {
    static int grid = 0;
    if (grid == 0) {
        if (n_in != 21 || out_size != M * DM || ws_size < WS_END) { fprintf(stderr, "kernel_launch: unexpected sizes n_in %d out %d ws %zu\n", n_in, out_size, ws_size); grid = -1; return; }
        int dev = 0, cus = 0, per_cu = 0;
        hipGetDevice(&dev); hipDeviceGetAttribute(&cus, hipDeviceAttributeMultiprocessorCount, dev);
        if (hipFuncSetAttribute((const void*)mk_fwd, hipFuncAttributeMaxDynamicSharedMemorySize, LDS_BYTES) != hipSuccess) { fprintf(stderr, "kernel_launch: hipFuncSetAttribute failed\n"); grid = -1; return; }
        if (hipOccupancyMaxActiveBlocksPerMultiprocessor(&per_cu, (const void*)mk_fwd, 512, LDS_BYTES) != hipSuccess || per_cu < 1) { fprintf(stderr, "kernel_launch: occupancy query gave %d\n", per_cu); per_cu = 1; }
        (void)hipGetLastError();
        grid = cus * 1;
        fprintf(stderr, "kernel_launch: cus %d per_cu %d grid %d\n", cus, per_cu, grid);
    }
    if (grid < 0) return;
    if (hipMemsetAsync((char*)d_ws + WS_BAR, 0, XCD_BAR_WORDS * 4, stream) != hipSuccess) { fprintf(stderr, "kernel_launch: memset of barrier words failed\n"); return; }
    Args a{};
    for (int i = 0; i < 21; ++i) a.in[i] = (const float*)d_in[i];
    a.out = (float*)d_out; a.ws = (unsigned char*)d_ws;
#if MK_N_LAUNCHES == 1
    a.ph_lo = 0; a.ph_hi = N_PHASES;
    void* kargs[] = {&a};
    hipError_t e = hipLaunchCooperativeKernel((const void*)mk_fwd, dim3(grid), dim3(512), kargs, LDS_BYTES, stream);
    if (e != hipSuccess) fprintf(stderr, "kernel_launch: cooperative launch failed: %s (grid %d)\n", hipGetErrorString(e), grid);
#else
    for (int ph = 0; ph < N_PHASES; ++ph) {
        a.ph_lo = ph; a.ph_hi = ph + 1;
        void* kargs[] = {&a};
        hipError_t e = hipLaunchCooperativeKernel((const void*)mk_fwd, dim3(grid), dim3(512), kargs, LDS_BYTES, stream);
        if (e != hipSuccess) { fprintf(stderr, "kernel_launch: launch %d failed: %s (grid %d)\n", ph, hipGetErrorString(e), grid); break; }
    }
#endif
}
```

```cpp
#include <hip/hip_runtime.h>
#include <hip/hip_cooperative_groups.h>
#include <cstdio>
#include <cstdint>
namespace cg = cooperative_groups;

#ifndef MK_N_LAUNCHES
#define MK_N_LAUNCHES 1
#endif

#define LAS __attribute__((address_space(3)))
typedef unsigned short bf16_t;
typedef short bf16x8 __attribute__((ext_vector_type(8)));
typedef float f32x4 __attribute__((ext_vector_type(4)));
typedef float f32x2 __attribute__((ext_vector_type(2)));
typedef unsigned u32x4 __attribute__((ext_vector_type(4)));
typedef unsigned u32x2 __attribute__((ext_vector_type(2)));

constexpr int BATCH = 2, SEQ = 16384, M = BATCH * SEQ, DM = 2048, INC = 7168, FF = 5632, PLE = 256;
constexpr int NHEAD = 8, NCHUNK = SEQ / 64;
constexpr float EPS = 1e-6f;
constexpr int C_Q = 0, C_ZF = 1024, C_ZB = 2048, C_I = 3072, C_G = 4096, C_U = 5120, C_V = 6144;
constexpr size_t PT_TILE = 8192, PT_SEG = 8 * PT_TILE, PT_CHUNK = 7 * PT_SEG;

constexpr size_t MiB = 1u << 20;
constexpr size_t WS_CTL = 0;
constexpr size_t WS_WIN = 1 * MiB, WS_WOUT = 29 * MiB, WS_WGU = 37 * MiB, WS_WDN = 81 * MiB, WS_WPG = 103 * MiB, WS_WPP = 111 * MiB, WS_SGUW = 112 * MiB;
constexpr size_t WS_PBF = 113 * MiB, WS_DEC = 129 * MiB, WS_PROJ = 133 * MiB, WS_CAT = 581 * MiB, WS_HB = 709 * MiB, WS_SEG = 965 * MiB, WS_CARRY = 981 * MiB, WS_DSEG = 997 * MiB, WS_END = 998 * MiB;
constexpr size_t WS_ACT = WS_PROJ, WS_PP = WS_CAT, WS_S = WS_HB;
constexpr int CT_LBF = 0, CT_LBB = 1024, CT_VSUM = 16384, CT_VSSQ = CT_VSUM + M, CT_SSQ1 = CT_VSSQ + M, CT_SSQ2 = CT_SSQ1 + M, CT_SSQ3 = CT_SSQ2 + M;
static_assert((size_t)(CT_SSQ3 + M) * 4 <= 1 * MiB, "ctl");

constexpr int LDS_BYTES = 163840;
constexpr size_t WS_BAR = 768 * 1024;
constexpr int LDS_BARST = 163584;

typedef __bf16 bf16v2 __attribute__((ext_vector_type(2)));
__device__ __forceinline__ unsigned cvt_pk_bf16(float lo, float hi) { const f32x2 v = {lo, hi}; const bf16v2 r = __builtin_convertvector(v, bf16v2); return __builtin_bit_cast(unsigned, r); }
__device__ __forceinline__ float bf2f(unsigned short h) { return __uint_as_float((unsigned)h << 16); }
__device__ __forceinline__ float bflo(unsigned w) { return __uint_as_float(w << 16); }
__device__ __forceinline__ float bfhi(unsigned w) { return __uint_as_float(w & 0xffff0000u); }
__device__ __forceinline__ float h2f(unsigned short h) { return (float)__builtin_bit_cast(_Float16, h); }
__device__ __forceinline__ unsigned short f2h(float f) { return __builtin_bit_cast(unsigned short, (_Float16)f); }
__device__ __forceinline__ float fsigmoid(float x) { return __builtin_amdgcn_rcpf(1.0f + __expf(-x)); }
__device__ __forceinline__ float fsilu(float x) { return x * fsigmoid(x); }
__device__ __forceinline__ float wave_sum(float v) {
#pragma unroll
    for (int o = 1; o < 64; o <<= 1) v += __shfl_xor(v, o);
    return v;
}
__device__ __forceinline__ void atomic_addf(float* p, float v) { __hip_atomic_fetch_add(p, v, __ATOMIC_RELAXED, __HIP_MEMORY_SCOPE_AGENT); }
__device__ __forceinline__ float gelu1(float v) {
    const float av = __builtin_fabsf(v), t = __builtin_amdgcn_rcpf(av * 0.2316418882f + 1.0f);
    float q = t * 0.5307027145f + (-0.7265760135f); q = q * t + 0.7107068705f; q = q * t + (-0.142248368f); q = q * t + 0.127414796f; q = q * t;
    const float e = __builtin_amdgcn_exp2f((v * v) * (-0.72134752044f));
    const float m = v * (q * e);
    return v < 0.f ? m : v - m;
}

__device__ __forceinline__ int fresh_tid();
typedef _Float16 f16v2 __attribute__((ext_vector_type(2)));
__device__ __forceinline__ f32x2 exp2_pk(f32x2 v) { f32x2 r; r.x = __builtin_amdgcn_exp2f(v.x); r.y = __builtin_amdgcn_exp2f(v.y); return r; }
__device__ __forceinline__ f32x2 rcp_pk(f32x2 v) { f32x2 r; r.x = __builtin_amdgcn_rcpf(v.x); r.y = __builtin_amdgcn_rcpf(v.y); return r; }
__device__ __forceinline__ f32x2 log2_pk(f32x2 v) { f32x2 r; r.x = __builtin_amdgcn_logf(v.x); r.y = __builtin_amdgcn_logf(v.y); return r; }
__device__ __forceinline__ f32x2 sigmoid_pk(f32x2 x) { return rcp_pk(exp2_pk(x * (-1.4426950408889634f)) + 1.0f); }
__device__ __forceinline__ f32x2 silu_pk(f32x2 x) { return x * sigmoid_pk(x); }
__device__ __forceinline__ f32x2 gelu_pk(f32x2 v) {
    const f32x2 av = __builtin_elementwise_abs(v), d = av * 0.2316418882f + 1.0f;
    const f32x2 t = rcp_pk(d);
    f32x2 q = t * 0.5307027145f + (-0.7265760135f); q = q * t + 0.7107068705f; q = q * t + (-0.142248368f); q = q * t + 0.127414796f; q = q * t;
    const f32x2 e = exp2_pk((v * v) * (-0.72134752044f));
    const f32x2 m = v * (q * e), r = v - m;
    f32x2 o; o.x = v.x < 0.f ? m.x : r.x; o.y = v.y < 0.f ? m.y : r.y; return o;
}
__device__ __forceinline__ unsigned cvt_pk_bf16v(f32x2 v) { const bf16v2 r = __builtin_convertvector(v, bf16v2); return __builtin_bit_cast(unsigned, r); }
__device__ __forceinline__ unsigned cvt_pk_f16v(f32x2 v) { const f16v2 r = __builtin_convertvector(v, f16v2); return __builtin_bit_cast(unsigned, r); }
namespace pg8 {
constexpr int BM = 256, BK = 64, HALF = 128, HTB = HALF * BK * 2, STAGE_BYTES = 8 * HTB, NXCD = 8, WGM = 8;
__host__ __device__ __forceinline__ int lds_byte(int r, int c) { const int st = (r >> 4) * 2 + (c >> 5), rr = r & 15, cc = c & 31, ob = rr * 64 + cc * 2; return st * 1024 + (ob ^ (((ob >> 9) & 1) << 5)); }
__host__ __device__ __forceinline__ void stage_rc(int b, int& R, int& C) { const int st = b / 1024, sb = b % 1024, swz = sb ^ (((sb >> 9) & 1) << 5); R = (st >> 1) * 16 + swz / 64; C = (st & 1) * 32 + (swz % 64) / 2; }
__host__ __device__ __forceinline__ int perm32(int rho) { const int n = rho >> 4, i = rho & 15; return 8 * (i >> 2) + 4 * n + (i & 3); }

struct Unit { int pm, pn; };
struct Gemm { const bf16_t* A; const bf16_t* Bt; int M, N, K; };

struct StaticOrder {
    int nM, nN, nwg, G, c;
    __host__ __device__ __forceinline__ void init(int M_, int N_, int G_, int c_) { nM = M_ / BM; nN = N_ / BM; nwg = nM * nN; G = G_; c = c_; }
    __host__ __device__ __forceinline__ bool next(int i, Unit& u) const {
        const long L = (long)i * G + c; if (L >= nwg) return false;
        int wgid = (int)L; { const int q = nwg / NXCD, r = nwg % NXCD, xcd = wgid % NXCD, off = wgid / NXCD; wgid = (xcd < r ? xcd * (q + 1) : r * (q + 1) + (xcd - r) * q) + off; }
        const int nig = WGM * nN, gid = wgid / nig, fm = gid * WGM, gsz = (nM - fm) < WGM ? (nM - fm) : WGM;
        u.pm = fm + ((wgid % nig) % gsz); u.pn = (wgid % nig) / gsz; return true;
    }
};

typedef f32x4 Acc[2][2][4][2];

template <class Epi, class Sched, bool ALIGN_EPI = true>
__device__ __forceinline__ void gemm_phase(LAS unsigned char* lds, const Gemm g, const Sched& S, const Epi& E) {
    const int tid = fresh_tid(), wid = __builtin_amdgcn_readfirstlane(tid >> 6), lane = tid & 63, wr = wid >> 2, wc = wid & 3, fr = lane & 15, fq = lane >> 4;
    const int K = g.K, nt = K / BK;
    unsigned voffA[2], voffB[2];
#pragma unroll
    for (int i = 0; i < 2; ++i) { int R, C; stage_rc(tid * 16 + i * 8192, R, C); const int Rb = Epi::PERM ? ((R & ~31) + perm32(R & 31)) : R;
        voffA[i] = (unsigned)(R * K + C) * 2u; voffB[i] = (unsigned)(Rb * K + C) * 2u; }
    const size_t kstep = (size_t)(BK * 2);
    const size_t hstep = (size_t)HALF * K * 2;
    const size_t tstep = 2 * hstep;
    const unsigned ldsw = (unsigned)wid * 1024u;
    const int aoff = lds_byte(wr * 64 + fr, fq * 8), boff = lds_byte(wc * 32 + fr, fq * 8);
#define PG8_SA(b, h) (((b) * 2 + (h)) * HTB)
#define PG8_SB(b, h) ((4 + (b) * 2 + (h)) * HTB)
#define PG8_STAGE(bufoff, gbase, voff) do { _Pragma("unroll") for (int _i = 0; _i < 2; ++_i) \
        __builtin_amdgcn_global_load_lds((const unsigned*)((const char*)(gbase) + (voff)[_i]), (LAS unsigned*)(lds + (bufoff) + ldsw + _i * 8192), 16, 0, 0); } while (0)
#define PG8_LDA(dst, b, h) do { _Pragma("unroll") for (int m = 0; m < 4; ++m) _Pragma("unroll") for (int k = 0; k < 2; ++k) dst[m][k] = *(const LAS bf16x8*)(lds + PG8_SA(b, h) + aoff + m * 2048 + k * 1024); } while (0)
#define PG8_LDB(dst, b, h) do { _Pragma("unroll") for (int n = 0; n < 2; ++n) _Pragma("unroll") for (int k = 0; k < 2; ++k) dst[n][k] = *(const LAS bf16x8*)(lds + PG8_SB(b, h) + boff + n * 2048 + k * 1024); } while (0)
#define PG8_MMA(ai, bj, At, Bt) do { __builtin_amdgcn_s_setprio(1); _Pragma("unroll") for (int m = 0; m < 4; ++m) _Pragma("unroll") for (int n = 0; n < 2; ++n) _Pragma("unroll") for (int k = 0; k < 2; ++k) \
        acc[ai][bj][m][n] = __builtin_amdgcn_mfma_f32_16x16x32_bf16(Bt[n][k], At[m][k], acc[ai][bj][m][n], 0, 0, 0); __builtin_amdgcn_s_setprio(0); } while (0)
#define PG8_WAIT_V(n) asm volatile("s_waitcnt vmcnt(" #n ")" ::: "memory")
#define PG8_WAIT_L(n) asm volatile("s_waitcnt lgkmcnt(" #n ")" ::: "memory")
#define PG8_BAR __builtin_amdgcn_s_barrier()
#define PG8_SCHED __builtin_amdgcn_sched_barrier(0)
    int tab_pm = -1, tab_pn = 0;
    { Unit uu; if (S.next(lane, uu)) { tab_pm = uu.pm; tab_pn = uu.pn; } }
#define PG8_NEXT(i, u) ((u).pm = __builtin_amdgcn_readlane(tab_pm, (i)), (u).pn = __builtin_amdgcn_readlane(tab_pn, (i)), (u).pm >= 0)
    Unit cur, nxt; int ui = 0;
    if (!PG8_NEXT(0, cur)) return;
    Acc acc;
#pragma unroll
    for (int a = 0; a < 2; ++a)
#pragma unroll
        for (int b = 0; b < 2; ++b)
#pragma unroll
            for (int m = 0; m < 4; ++m)
#pragma unroll
                for (int n = 0; n < 2; ++n) acc[a][b][m][n] = (f32x4){0.f, 0.f, 0.f, 0.f};
    bf16x8 At[4][2], B0[2][2], B1[2][2];
    const char* cA = (const char*)g.A + (size_t)cur.pm * tstep; const char* cB = (const char*)g.Bt + (size_t)cur.pn * tstep;
    PG8_STAGE(PG8_SB(0, 0), cB, voffB); PG8_STAGE(PG8_SB(0, 1), cB + hstep, voffB); PG8_STAGE(PG8_SA(0, 0), cA, voffA); PG8_STAGE(PG8_SA(0, 1), cA + hstep, voffA);
    if (wr == 1) PG8_BAR;
    PG8_WAIT_V(2); PG8_BAR;
    PG8_STAGE(PG8_SB(1, 0), cB + kstep, voffB); PG8_STAGE(PG8_SA(1, 0), cA + kstep, voffA); PG8_STAGE(PG8_SB(1, 1), cB + hstep + kstep, voffB);
    PG8_WAIT_V(6); PG8_BAR;
    for (;;) {
        const bool has_next = PG8_NEXT(ui + 1, nxt);
        const char* nA = has_next ? (const char*)g.A + (size_t)nxt.pm * tstep : cA; const char* nB = has_next ? (const char*)g.Bt + (size_t)nxt.pn * tstep : cB;
        for (int t = 0; t < nt; t += 2) {
            const bool last = (t == nt - 2);
            const char* a1 = cA + (size_t)(t + 1) * kstep;
            const char* a2 = last ? nA : cA + (size_t)(t + 2) * kstep; const char* b2 = last ? nB : cB + (size_t)(t + 2) * kstep;
            const char* a3 = a2 + kstep; const char* b3 = b2 + kstep;
            PG8_LDB(B0, 0, 0); PG8_LDB(B1, 0, 1); PG8_SCHED; PG8_LDA(At, 0, 0); PG8_STAGE(PG8_SA(1, 1), a1 + hstep, voffA);
            PG8_WAIT_V(8); PG8_WAIT_L(0); PG8_BAR; PG8_MMA(0, 0, At, B0); PG8_MMA(0, 1, At, B1); PG8_BAR; PG8_SCHED;
            PG8_LDA(At, 0, 1); PG8_STAGE(PG8_SB(0, 0), b2, voffB); PG8_STAGE(PG8_SB(0, 1), b2 + hstep, voffB); PG8_STAGE(PG8_SA(0, 0), a2, voffA);
            PG8_WAIT_V(8); PG8_WAIT_L(0); PG8_BAR; PG8_MMA(1, 0, At, B0); PG8_MMA(1, 1, At, B1); PG8_BAR; PG8_SCHED;
            PG8_LDB(B0, 1, 0); PG8_LDB(B1, 1, 1); PG8_SCHED; PG8_LDA(At, 1, 0); PG8_STAGE(PG8_SA(0, 1), a2 + hstep, voffA);
            PG8_WAIT_V(8); PG8_WAIT_L(0); PG8_BAR; PG8_MMA(0, 0, At, B0); PG8_MMA(0, 1, At, B1); PG8_BAR; PG8_SCHED;
            PG8_LDA(At, 1, 1); PG8_STAGE(PG8_SB(1, 0), b3, voffB); PG8_STAGE(PG8_SB(1, 1), b3 + hstep, voffB); PG8_STAGE(PG8_SA(1, 0), a3, voffA);
            PG8_WAIT_V(8); PG8_WAIT_L(0); PG8_BAR; PG8_MMA(1, 0, At, B0); PG8_MMA(1, 1, At, B1); PG8_BAR; PG8_SCHED;
        }
        if constexpr (ALIGN_EPI) { if (wr == 0) PG8_BAR; }
        E(acc, cur, wr, wc, fr, fq);
        if (!has_next) break;
#pragma unroll
        for (int a = 0; a < 2; ++a)
#pragma unroll
            for (int b = 0; b < 2; ++b)
#pragma unroll
                for (int m = 0; m < 4; ++m)
#pragma unroll
                    for (int n = 0; n < 2; ++n) acc[a][b][m][n] = (f32x4){0.f, 0.f, 0.f, 0.f};
        cur = nxt; cA = nA; cB = nB; ++ui;
        if constexpr (ALIGN_EPI) { if (wr == 1) PG8_BAR; }
    }
    PG8_WAIT_V(0);
    if constexpr (!ALIGN_EPI) { if (wr == 0) PG8_BAR; }
    PG8_BAR;
#undef PG8_SA
#undef PG8_SB
#undef PG8_STAGE
#undef PG8_LDA
#undef PG8_LDB
#undef PG8_MMA
#undef PG8_WAIT_V
#undef PG8_NEXT
#undef PG8_WAIT_L
#undef PG8_BAR
#undef PG8_SCHED
}
}
using pg8::Acc; using pg8::Unit;

#define EPI_FENCE() asm volatile("" ::: "memory")

struct EpiIn {
    static constexpr bool PERM = true;
    bf16_t* O; const float* lbf; const float* lbb; float* vsum; float* vssq; int seg_base;
    template <int SEG> __device__ __forceinline__ void body(const Acc& acc, const Unit& u, int wr, int wc, int fr, int fq) const {
        const int row0 = u.pm * 256 + wr * 64 + fr, col0 = u.pn * 256 + wc * 32 + 8 * fq;
        f32x2 lb[2][4], oml[2][4];
        if (SEG == 1 || SEG == 2) {
            const float* lp = (SEG == 1 ? lbf : lbb) + (col0 - SEG * 1024);
#pragma unroll
            for (int bj = 0; bj < 2; ++bj)
#pragma unroll
                for (int e = 0; e < 4; ++e) { lb[bj][e] = (f32x2){lp[bj * 128 + 2 * e], lp[bj * 128 + 2 * e + 1]}; oml[bj][e] = 1.0f - lb[bj][e]; }
        }
#pragma unroll
        for (int ai = 0; ai < 2; ++ai)
#pragma unroll
            for (int m = 0; m < 4; ++m) {
                const int row = row0 + ai * 128 + m * 16;
                bf16_t* rowp = O + (size_t)(u.pm * 4 + ai * 2 + wr) * PT_CHUNK + (size_t)SEG * PT_SEG + (size_t)((u.pn & 3) * 2) * PT_TILE + (m * 16 + fr) * 128 + wc * 32 + 8 * fq;
                f32x2 s1 = {0.f, 0.f}, s2 = {0.f, 0.f};
#pragma unroll
                for (int bj = 0; bj < 2; ++bj) {
                    f32x2 v[4];
                    v[0] = (f32x2){acc[ai][bj][m][0][0], acc[ai][bj][m][0][1]}; v[1] = (f32x2){acc[ai][bj][m][0][2], acc[ai][bj][m][0][3]};
                    v[2] = (f32x2){acc[ai][bj][m][1][0], acc[ai][bj][m][1][1]}; v[3] = (f32x2){acc[ai][bj][m][1][2], acc[ai][bj][m][1][3]};
                    u32x4 w;
                    if (SEG == 1 || SEG == 2) {
                        unsigned hw[4];
#pragma unroll
                        for (int e = 0; e < 4; ++e) { const f32x2 f = lb[bj][e] + oml[bj][e] * sigmoid_pk(v[e]); hw[e] = cvt_pk_f16v(log2_pk(f) * 0.6931471805599453f); }
                        w.x = hw[0]; w.y = hw[1]; w.z = hw[2]; w.w = hw[3];
                    } else {
#pragma unroll
                        for (int e = 0; e < 4; ++e) {
                            if (SEG == 0 || SEG == 4) v[e] = silu_pk(v[e]);
                            if (SEG == 5 || SEG == 6) v[e] = gelu_pk(v[e]);
                            if (SEG == 6) { s1 += v[e]; s2 += v[e] * v[e]; }
                        }
                        w.x = cvt_pk_bf16v(v[0]); w.y = cvt_pk_bf16v(v[1]); w.z = cvt_pk_bf16v(v[2]); w.w = cvt_pk_bf16v(v[3]);
                    }
                    *(u32x4*)(rowp + bj * PT_TILE) = w;
                    EPI_FENCE();
                }
                if (SEG == 6) {
                    float a1 = s1.x + s1.y, a2 = s2.x + s2.y;
                    a1 += __shfl_xor(a1, 16); a1 += __shfl_xor(a1, 32); a2 += __shfl_xor(a2, 16); a2 += __shfl_xor(a2, 32);
                    if (fq == 0) { atomic_addf(vsum + row, a1); atomic_addf(vssq + row, a2); }
                }
            }
    }
    __device__ __forceinline__ void operator()(const Acc& acc, const Unit& u, int wr, int wc, int fr, int fq) const {
        switch ((u.pn >> 2) + seg_base) {
            case 0: body<0>(acc, u, wr, wc, fr, fq); break;
            case 1: body<1>(acc, u, wr, wc, fr, fq); break;
            case 2: body<2>(acc, u, wr, wc, fr, fq); break;
            case 3: body<3>(acc, u, wr, wc, fr, fq); break;
            case 4: body<4>(acc, u, wr, wc, fr, fq); break;
            case 5: body<5>(acc, u, wr, wc, fr, fq); break;
            default: body<6>(acc, u, wr, wc, fr, fq); break;
        }
    }
};
struct EpiInT {
    static constexpr bool PERM = true;
    bf16_t* O; const float* lbf; const float* lbb;
    template <int SEG> __device__ __forceinline__ void body(const Acc& acc, const Unit& u, int wr, int wc, int fr, int fq) const {
        const int chunk0 = u.pn * 4 + (wc >> 1), s0 = 32 * (wc & 1) + 8 * fq;
        float lbv[2][4];
        if (SEG == 1 || SEG == 2) {
            const float* lp = (SEG == 1 ? lbf : lbb) + (u.pm & 3) * 256 + 64 * wr + fr;
#pragma unroll
            for (int ai = 0; ai < 2; ++ai)
#pragma unroll
                for (int m = 0; m < 4; ++m) lbv[ai][m] = lp[ai * 128 + 16 * m];
        }
#pragma unroll
        for (int ai = 0; ai < 2; ++ai)
#pragma unroll
            for (int m = 0; m < 4; ++m) {
                const int hh = (u.pm & 3) * 2 + ai, kk = 64 * wr + 16 * m + fr;
                bf16_t* tp = O + (size_t)SEG * PT_SEG + (size_t)hh * PT_TILE + kk * 64 + s0;
                const float l = (SEG == 1 || SEG == 2) ? lbv[ai][m] : 0.f, oml = 1.0f - l;
#pragma unroll
                for (int bj = 0; bj < 2; ++bj) {
                    f32x2 v[4];
                    v[0] = (f32x2){acc[ai][bj][m][0][0], acc[ai][bj][m][0][1]}; v[1] = (f32x2){acc[ai][bj][m][0][2], acc[ai][bj][m][0][3]};
                    v[2] = (f32x2){acc[ai][bj][m][1][0], acc[ai][bj][m][1][1]}; v[3] = (f32x2){acc[ai][bj][m][1][2], acc[ai][bj][m][1][3]};
                    u32x4 w;
                    if (SEG == 1 || SEG == 2) {
                        unsigned hw[4];
#pragma unroll
                        for (int e = 0; e < 4; ++e) { const f32x2 f = sigmoid_pk(v[e]) * oml + l; hw[e] = cvt_pk_f16v(log2_pk(f) * 0.6931471805599453f); }
                        w.x = hw[0]; w.y = hw[1]; w.z = hw[2]; w.w = hw[3];
                    } else {
                        if (SEG == 0) {
#pragma unroll
                            for (int e = 0; e < 4; ++e) v[e] = silu_pk(v[e]);
                        }
                        w.x = cvt_pk_bf16v(v[0]); w.y = cvt_pk_bf16v(v[1]); w.z = cvt_pk_bf16v(v[2]); w.w = cvt_pk_bf16v(v[3]);
                    }
                    *(u32x4*)(tp + (size_t)(chunk0 + 2 * bj) * PT_CHUNK) = w;
                    EPI_FENCE();
                }
            }
    }
    __device__ __forceinline__ void operator()(const Acc& acc, const Unit& u, int wr, int wc, int fr, int fq) const {
        switch (u.pm >> 2) {
            case 0: body<0>(acc, u, wr, wc, fr, fq); break;
            case 1: body<1>(acc, u, wr, wc, fr, fq); break;
            case 2: body<2>(acc, u, wr, wc, fr, fq); break;
            default: body<3>(acc, u, wr, wc, fr, fq); break;
        }
    }
};
template <bool BB> struct EpiRes {
    static constexpr bool PERM = true;
    const float* base; bf16_t* hb; float* ssq;
    __device__ __forceinline__ void operator()(const Acc& acc, const Unit& u, int wr, int wc, int fr, int fq) const {
        const int row0 = u.pm * 256 + wr * 64 + fr, col0 = u.pn * 256 + wc * 32 + 8 * fq;
#pragma unroll
        for (int ai = 0; ai < 2; ++ai) {
            f32x4 bv[4][2][2]; u32x4 bw[4][2];
#pragma unroll
            for (int m = 0; m < 4; ++m) { const size_t off = (size_t)(row0 + ai * 128 + m * 16) * DM + col0;
#pragma unroll
                for (int bj = 0; bj < 2; ++bj) {
                    if (BB) bw[m][bj] = *(const u32x4*)(hb + off + bj * 128);
                    else { bv[m][bj][0] = *(const f32x4*)(base + off + bj * 128); bv[m][bj][1] = *(const f32x4*)(base + off + bj * 128 + 4); } } }
            EPI_FENCE();
#pragma unroll
            for (int m = 0; m < 4; ++m) {
                const int row = row0 + ai * 128 + m * 16; const size_t off = (size_t)row * DM + col0;
                float s2 = 0.f;
#pragma unroll
                for (int bj = 0; bj < 2; ++bj) {
                    f32x4 b0, b1;
                    if (BB) { const u32x4 q = bw[m][bj]; b0 = (f32x4){bflo(q.x), bfhi(q.x), bflo(q.y), bfhi(q.y)}; b1 = (f32x4){bflo(q.z), bfhi(q.z), bflo(q.w), bfhi(q.w)}; }
                    else { b0 = bv[m][bj][0]; b1 = bv[m][bj][1]; }
                    const f32x4 h0 = b0 + acc[ai][bj][m][0], h1 = b1 + acc[ai][bj][m][1];
                    u32x4 w; w.x = cvt_pk_bf16(h0[0], h0[1]); w.y = cvt_pk_bf16(h0[2], h0[3]); w.z = cvt_pk_bf16(h1[0], h1[1]); w.w = cvt_pk_bf16(h1[2], h1[3]);
                    *(u32x4*)(hb + off + bj * 128) = w;
                    s2 += (h0[0] * h0[0] + h0[1] * h0[1]) + (h0[2] * h0[2] + h0[3] * h0[3]) + (h1[0] * h1[0] + h1[1] * h1[1]) + (h1[2] * h1[2] + h1[3] * h1[3]);
                }
                s2 += __shfl_xor(s2, 16); s2 += __shfl_xor(s2, 32);
                if (fq == 0) atomic_addf(ssq + row, s2);
            }
            EPI_FENCE();
        }
    }
};
struct EpiGU {
    static constexpr bool PERM = true;
    bf16_t* act; const float* ssq;
    __device__ __forceinline__ void operator()(const Acc& acc, const Unit& u, int wr, int wc, int fr, int fq) const {
        const int row0 = u.pm * 256 + wr * 64 + fr, col0 = u.pn * 128 + wc * 32 + 8 * fq;
        float rsv[2][4];
#pragma unroll
        for (int ai = 0; ai < 2; ++ai)
#pragma unroll
            for (int m = 0; m < 4; ++m) rsv[ai][m] = ssq[row0 + ai * 128 + m * 16];
        EPI_FENCE();
#pragma unroll
        for (int ai = 0; ai < 2; ++ai)
#pragma unroll
            for (int m = 0; m < 4; ++m) {
                const int row = row0 + ai * 128 + m * 16;
                const float rs = __builtin_amdgcn_rsqf(rsv[ai][m] * (1.0f / DM) + EPS);
                const float nrs = rs * (-1.4426950408889634f), rs2 = rs * rs;
                unsigned ow[4];
#pragma unroll
                for (int e = 0; e < 4; ++e) {
                    const f32x2 g2 = {acc[ai][0][m][e >> 1][2 * (e & 1)], acc[ai][0][m][e >> 1][2 * (e & 1) + 1]}, u2 = {acc[ai][1][m][e >> 1][2 * (e & 1)], acc[ai][1][m][e >> 1][2 * (e & 1) + 1]};
                    ow[e] = cvt_pk_bf16v((g2 * u2) * (rcp_pk(exp2_pk(g2 * nrs) + 1.0f) * rs2));
                }
                u32x4 w; w.x = ow[0]; w.y = ow[1]; w.z = ow[2]; w.w = ow[3];
                *(u32x4*)(act + (size_t)row * FF + col0) = w;
                EPI_FENCE();
            }
    }
};
struct EpiPP {
    static constexpr bool PERM = true;
    bf16_t* O;
    __device__ __forceinline__ void operator()(const Acc& acc, const Unit& u, int wr, int wc, int fr, int fq) const {
        const int row0 = u.pm * 256 + wr * 64 + fr, col0 = u.pn * 256 + wc * 32 + 8 * fq;
#pragma unroll
        for (int ai = 0; ai < 2; ++ai)
#pragma unroll
            for (int m = 0; m < 4; ++m) {
                bf16_t* rowp = O + (size_t)(row0 + ai * 128 + m * 16) * DM + col0;
#pragma unroll
                for (int bj = 0; bj < 2; ++bj) {
                    const f32x4 v0 = acc[ai][bj][m][0], v1 = acc[ai][bj][m][1];
                    u32x4 w; w.x = cvt_pk_bf16(v0[0], v0[1]); w.y = cvt_pk_bf16(v0[2], v0[3]); w.z = cvt_pk_bf16(v1[0], v1[1]); w.w = cvt_pk_bf16(v1[2], v1[3]);
                    *(u32x4*)(rowp + bj * 128) = w;
                    EPI_FENCE();
                }
            }
    }
};
struct EpiPle {
    static constexpr bool PERM = true;
    const bf16_t* hb; bf16_t* h3b; const bf16_t* pp; const float* ssq_in; float* ssq_out;
    __device__ __forceinline__ void operator()(const Acc& acc, const Unit& u, int wr, int wc, int fr, int fq) const {
        const int row0 = u.pm * 256 + wr * 64 + fr, col0 = u.pn * 256 + wc * 32 + 8 * fq;
#pragma unroll
        for (int ai = 0; ai < 2; ++ai) {
            u32x4 bw[4][2], pw[4][2]; float rsv[4];
#pragma unroll
            for (int m = 0; m < 4; ++m) { const int row = row0 + ai * 128 + m * 16; const size_t off = (size_t)row * DM + col0;
                rsv[m] = ssq_in[row];
#pragma unroll
                for (int bj = 0; bj < 2; ++bj) { bw[m][bj] = *(const u32x4*)(hb + off + bj * 128); pw[m][bj] = *(const u32x4*)(pp + off + bj * 128); } }
            EPI_FENCE();
#pragma unroll
            for (int m = 0; m < 4; ++m) {
                const int row = row0 + ai * 128 + m * 16; const size_t off = (size_t)row * DM + col0;
                const float rs = __builtin_amdgcn_rsqf(rsv[m] * (1.0f / DM) + EPS);
                float s2 = 0.f;
#pragma unroll
                for (int bj = 0; bj < 2; ++bj) {
                    const u32x4 q = bw[m][bj], pq = pw[m][bj];
                    f32x4 h0, h1;
                    h0[0] = bflo(q.x) + fsigmoid(acc[ai][bj][m][0][0] * rs) * bflo(pq.x); h0[1] = bfhi(q.x) + fsigmoid(acc[ai][bj][m][0][1] * rs) * bfhi(pq.x);
                    h0[2] = bflo(q.y) + fsigmoid(acc[ai][bj][m][0][2] * rs) * bflo(pq.y); h0[3] = bfhi(q.y) + fsigmoid(acc[ai][bj][m][0][3] * rs) * bfhi(pq.y);
                    h1[0] = bflo(q.z) + fsigmoid(acc[ai][bj][m][1][0] * rs) * bflo(pq.z); h1[1] = bfhi(q.z) + fsigmoid(acc[ai][bj][m][1][1] * rs) * bfhi(pq.z);
                    h1[2] = bflo(q.w) + fsigmoid(acc[ai][bj][m][1][2] * rs) * bflo(pq.w); h1[3] = bfhi(q.w) + fsigmoid(acc[ai][bj][m][1][3] * rs) * bfhi(pq.w);
                    u32x4 w; w.x = cvt_pk_bf16(h0[0], h0[1]); w.y = cvt_pk_bf16(h0[2], h0[3]); w.z = cvt_pk_bf16(h1[0], h1[1]); w.w = cvt_pk_bf16(h1[2], h1[3]);
                    *(u32x4*)(h3b + off + bj * 128) = w;
                    s2 += (h0[0] * h0[0] + h0[1] * h0[1]) + (h0[2] * h0[2] + h0[3] * h0[3]) + (h1[0] * h1[0] + h1[1] * h1[1]) + (h1[2] * h1[2] + h1[3] * h1[3]);
                }
                s2 += __shfl_xor(s2, 16); s2 += __shfl_xor(s2, 32);
                if (fq == 0) atomic_addf(ssq_out + row, s2);
            }
            EPI_FENCE();
        }
    }
};

struct Args { const float* in[21]; float* out; unsigned char* ws; int ph_lo, ph_hi; };
struct Frame {
    LAS unsigned char* lds; int G, bid;
    const float* const* in; float* out; unsigned char* ws;
};
__device__ __forceinline__ int fresh_tid() { int t = threadIdx.x; asm volatile("" : "+v"(t)); return t; }
#define PHASE_IDS() const int tid = fresh_tid(), lane = tid & 63, wave = __builtin_amdgcn_readfirstlane(tid >> 6); (void)lane; (void)wave
#define F_IN(i) (F.in[i])
#define F_x F_IN(0)
#define F_p F_IN(1)
#define F_norm_mix_g F_IN(2)
#define F_w_in F_IN(3)
#define F_lbfl F_IN(4)
#define F_lbbl F_IN(5)
#define F_onorm_g F_IN(6)
#define F_ln_g F_IN(7)
#define F_ln_b F_IN(8)
#define F_sgu_w F_IN(9)
#define F_sgu_b F_IN(10)
#define F_sgu_onorm F_IN(11)
#define F_w_out F_IN(12)
#define F_norm_ffn_g F_IN(13)
#define F_w_gate F_IN(14)
#define F_w_up F_IN(15)
#define F_w_down F_IN(16)
#define F_norm_ple_g F_IN(17)
#define F_w_pg F_IN(18)
#define F_w_pp F_IN(19)
#define F_final_g F_IN(20)
#define F_ctl ((float*)(F.ws + WS_CTL))
#define F_WIN ((bf16_t*)(F.ws + WS_WIN))
#define F_WOUT ((bf16_t*)(F.ws + WS_WOUT))
#define F_WGU ((bf16_t*)(F.ws + WS_WGU))
#define F_WDN ((bf16_t*)(F.ws + WS_WDN))
#define F_WPG ((bf16_t*)(F.ws + WS_WPG))
#define F_WPP ((bf16_t*)(F.ws + WS_WPP))
#define F_SGUW ((bf16_t*)(F.ws + WS_SGUW))
#define F_PBF ((bf16_t*)(F.ws + WS_PBF))
#define F_PROJ ((bf16_t*)(F.ws + WS_PROJ))
#define F_CAT ((bf16_t*)(F.ws + WS_CAT))
#define F_HB ((bf16_t*)(F.ws + WS_HB))
#define F_ACT ((bf16_t*)(F.ws + WS_ACT))
#define F_PP ((bf16_t*)(F.ws + WS_PP))
#define F_S ((bf16_t*)(F.ws + WS_S))
#define F_H3B ((bf16_t*)(F.ws + WS_ACT))
#define F_DEC ((float*)(F.ws + WS_DEC))
#define F_SEG ((bf16_t*)(F.ws + WS_SEG))
#define F_CARRY ((bf16_t*)(F.ws + WS_CARRY))
#define F_DSEG ((float*)(F.ws + WS_DSEG))
#define LDS_WAIT() asm volatile("s_waitcnt lgkmcnt(0)" ::: "memory")
#define LBAR() do { asm volatile("s_waitcnt lgkmcnt(0)" ::: "memory"); __builtin_amdgcn_s_barrier(); asm volatile("" ::: "memory"); } while (0)

constexpr int TRP = 136;
__device__ __forceinline__ void p0_transpose_item(const float* W, int K, int N, bf16_t* WT, const float* ksc, int mode, LAS unsigned char* scr, int item, int lane) {
    const int nblk = N / 64, kb = item / nblk, nb = item % nblk, k0 = 64 * kb, n0 = 64 * nb;
    const int lr = lane >> 4, lc = lane & 15;
#pragma unroll 8
    for (int i = 0; i < 16; ++i) { const int kk = 4 * i + lr; f32x4 v = *(const f32x4*)(W + (size_t)(k0 + kk) * N + n0 + 4 * lc); if (ksc) v = v * ksc[k0 + kk];
        u32x2 w; w.x = cvt_pk_bf16(v[0], v[1]); w.y = cvt_pk_bf16(v[2], v[3]); *(LAS u32x2*)(scr + kk * TRP + lc * 8) = w; }
    LDS_WAIT(); asm volatile("" ::: "memory");
    const int d0 = mode == 0 ? n0 : (256 * (n0 >> 7) + (n0 & 127) + (mode == 2 ? 128 : 0));
    const int c = lane & 7;
#pragma unroll
    for (int j = 0; j < 8; ++j) { const int n = (lane >> 3) + 8 * j; const LAS unsigned char* sp = scr + (8 * c) * TRP + n * 2;
        unsigned short e[8];
#pragma unroll
        for (int q = 0; q < 8; ++q) e[q] = *(const LAS unsigned short*)(sp + q * TRP);
        u32x4 o; o.x = e[0] | ((unsigned)e[1] << 16); o.y = e[2] | ((unsigned)e[3] << 16); o.z = e[4] | ((unsigned)e[5] << 16); o.w = e[6] | ((unsigned)e[7] << 16);
        *(u32x4*)(WT + (size_t)(d0 + n) * K + k0 + 8 * c) = o; }
    LDS_WAIT(); asm volatile("" ::: "memory");
}
__device__ __forceinline__ void p0_prologue(Frame& F) {
    PHASE_IDS();
    LAS unsigned char* scr = F.lds + wave * 16384;
    const int gw = F.bid * 8 + wave, NGW = F.G * 8;
    const int gt = F.bid * 512 + tid, NGT = F.G * 512;
    constexpr int I_IN = (DM / 64) * (INC / 64), I_OUT = (DM / 64) * (DM / 64), I_G = (DM / 64) * (FF / 64), I_DN = (FF / 64) * (DM / 64), I_PP = (PLE / 64) * (DM / 64);
    constexpr int NITEMS = I_IN + I_OUT + 2 * I_G + I_DN + I_OUT + I_PP;
    for (int it = gw; it < NITEMS; it += NGW) {
        int r = it;
        if (r < I_IN) { p0_transpose_item(F_w_in, DM, INC, F_WIN, nullptr, 0, scr, r, lane); continue; } r -= I_IN;
        if (r < I_OUT) { p0_transpose_item(F_w_out, DM, DM, F_WOUT, nullptr, 0, scr, r, lane); continue; } r -= I_OUT;
        if (r < I_G) { p0_transpose_item(F_w_gate, DM, FF, F_WGU, F_norm_ffn_g, 1, scr, r, lane); continue; } r -= I_G;
        if (r < I_G) { p0_transpose_item(F_w_up, DM, FF, F_WGU, F_norm_ffn_g, 2, scr, r, lane); continue; } r -= I_G;
        if (r < I_DN) { p0_transpose_item(F_w_down, FF, DM, F_WDN, nullptr, 0, scr, r, lane); continue; } r -= I_DN;
        if (r < I_OUT) { p0_transpose_item(F_w_pg, DM, DM, F_WPG, F_norm_ple_g, 0, scr, r, lane); continue; } r -= I_OUT;
        p0_transpose_item(F_w_pp, PLE, DM, F_WPP, nullptr, 0, scr, r, lane);
    }
    {
        f32x4 gv[8];
#pragma unroll
        for (int j = 0; j < 8; ++j) gv[j] = *((const f32x4*)F_norm_mix_g + lane + 64 * j);
        for (int m = gw; m < M; m += 2 * NGW) {
            const int m2 = (m + NGW < M) ? m + NGW : m;
            const f32x4* xr = (const f32x4*)(F_x + (size_t)m * DM) + lane; const f32x4* xr2 = (const f32x4*)(F_x + (size_t)m2 * DM) + lane;
            f32x4 v[8], v2[8]; float sa = 0.f, sb = 0.f;
#pragma unroll
            for (int j = 0; j < 8; ++j) { v[j] = xr[64 * j]; v2[j] = xr2[64 * j]; }
#pragma unroll
            for (int j = 0; j < 8; ++j) { sa += (v[j][0] * v[j][0] + v[j][1] * v[j][1]) + (v[j][2] * v[j][2] + v[j][3] * v[j][3]); sb += (v2[j][0] * v2[j][0] + v2[j][1] * v2[j][1]) + (v2[j][2] * v2[j][2] + v2[j][3] * v2[j][3]); }
            const float rs = __builtin_amdgcn_rsqf(wave_sum(sa) * (1.0f / DM) + EPS), rs2 = __builtin_amdgcn_rsqf(wave_sum(sb) * (1.0f / DM) + EPS);
            u32x2* o = (u32x2*)(F_HB + (size_t)m * DM) + lane; u32x2* o2 = (u32x2*)(F_HB + (size_t)m2 * DM) + lane;
#pragma unroll
            for (int j = 0; j < 8; ++j) { u32x2 w; w.x = cvt_pk_bf16(v[j][0] * rs * gv[j][0], v[j][1] * rs * gv[j][1]); w.y = cvt_pk_bf16(v[j][2] * rs * gv[j][2], v[j][3] * rs * gv[j][3]); o[64 * j] = w;
                u32x2 w2; w2.x = cvt_pk_bf16(v2[j][0] * rs2 * gv[j][0], v2[j][1] * rs2 * gv[j][1]); w2.y = cvt_pk_bf16(v2[j][2] * rs2 * gv[j][2], v2[j][3] * rs2 * gv[j][3]); o2[64 * j] = w2; }
        }
    }
    for (int i = gt; i < M * PLE / 4; i += NGT) { const f32x4 v = ((const f32x4*)F_p)[i]; u32x2 w; w.x = cvt_pk_bf16(v[0], v[1]); w.y = cvt_pk_bf16(v[2], v[3]); ((u32x2*)F_PBF)[i] = w; }
    for (int i = gt; i < 8 * 128 * 128 / 4; i += NGT) { const f32x4 v = ((const f32x4*)F_sgu_w)[i]; u32x2 w; w.x = cvt_pk_bf16(v[0], v[1]); w.y = cvt_pk_bf16(v[2], v[3]); ((u32x2*)F_SGUW)[i] = w; }
    for (int i = gt; i < 2048; i += NGT) { const float* l = (i < 1024) ? F_lbfl : F_lbbl; const int c = i & 1023; const float a = l[c], b = l[1024 + c], mx = fmaxf(a, b), ea = __expf(a - mx), eb = __expf(b - mx);
        F_ctl[(i < 1024 ? CT_LBF : CT_LBB) + c] = ea / (ea + eb); }
    for (int i = gt; i < 5 * M; i += NGT) F_ctl[CT_VSUM + i] = 0.f;
}

__device__ __forceinline__ bf16x8 ldfrag(const LAS unsigned char* base, int pitch, int row, int kbyte) { return *(const LAS bf16x8*)(base + row * pitch + kbyte); }
#define MFMA16(a, b, c) __builtin_amdgcn_mfma_f32_16x16x32_bf16((b), (a), (c), 0, 0, 0)

constexpr int P128 = 272, P64 = 144;
constexpr int H_QT = 0, H_KT = H_QT + 64 * P128, H_QTB = H_KT + 64 * P128, H_KTB = H_QTB + 64 * P128, H_SS = H_KTB + 64 * P128, H_VT = H_SS + 128 * P128, H_PB = H_VT + 128 * P64, H_TOT = H_PB + 64 * P64, H_RSX = H_TOT + 4096, H_KTH = H_RSX + 512, H_DLF = H_KTH + 128 * P64, H_END = H_DLF + 512;
constexpr int H_RAWF = 0, H_RAWB = 16384, H_RAWQ = 32768, H_RAWV = 49152;
static_assert(H_RAWV + 16384 <= H_SS && H_END <= LDS_BARST, "raw alias / lds");
static_assert(H_END <= LDS_BYTES, "lds");

__device__ __forceinline__ u32x4 pack8(const float* v) { u32x4 w; w.x = cvt_pk_bf16(v[0], v[1]); w.y = cvt_pk_bf16(v[2], v[3]); w.z = cvt_pk_bf16(v[4], v[5]); w.w = cvt_pk_bf16(v[6], v[7]); return w; }
__device__ __forceinline__ int invperm32(int kk) { return 16 * ((kk >> 2) & 1) + (((kk >> 3) << 2) | (kk & 3)); }
__device__ __forceinline__ unsigned short lds_u16(const LAS unsigned char* p) { return *(const LAS unsigned short*)p; }

constexpr int NSEGC = 16, NSEG = BATCH * NHEAD * (NCHUNK / NSEGC);
constexpr int T_KT = 0, T_DL = 4 * 128 * P64, T_END = T_DL + 2048;
static_assert(T_END <= LDS_BYTES, "s1 lds");
__device__ __forceinline__ void unpack_lf16(const u32x4 (&r)[2], float (&o)[16]) {
#pragma unroll
    for (int q = 0; q < 2; ++q)
#pragma unroll
        for (int e = 0; e < 4; ++e) { o[8 * q + 2 * e] = h2f((unsigned short)(r[q][e] & 0xffffu)) * 1.4426950408889634f; o[8 * q + 2 * e + 1] = h2f((unsigned short)(r[q][e] >> 16)) * 1.4426950408889634f; }
}
__device__ __forceinline__ void hgrn_s1(Frame& F) {
    LAS unsigned char* lds = F.lds;
    PHASE_IDS();
    const int k = tid >> 2, tq = tid & 3, w = wave, fr = lane & 15, fq = lane >> 4;
    const int kr = (k & ~31) + invperm32(k & 31);
    const int lq = lane & ~3;
    u32x4 rlf[2], rlb[2], raf[2], rab[2];
#define S1_LOAD(bh_, cf_, cb_) do { const bf16_t* tf_ = F_PROJ + (size_t)(((bh_) >> 3) * 256 + (cf_)) * PT_CHUNK + ((bh_) & 7) * PT_TILE; const bf16_t* tb_ = F_PROJ + (size_t)(((bh_) >> 3) * 256 + (cb_)) * PT_CHUNK + ((bh_) & 7) * PT_TILE; \
        rlf[0] = *(const u32x4*)(tf_ + 1 * PT_SEG + k * 64 + 16 * tq); rlf[1] = *(const u32x4*)(tf_ + 1 * PT_SEG + k * 64 + 16 * tq + 8); \
        rlb[0] = *(const u32x4*)(tb_ + 2 * PT_SEG + k * 64 + 16 * tq); rlb[1] = *(const u32x4*)(tb_ + 2 * PT_SEG + k * 64 + 16 * tq + 8); \
        raf[0] = *(const u32x4*)(tf_ + 3 * PT_SEG + (16 * w + fr) * 64 + 8 * fq); raf[1] = *(const u32x4*)(tf_ + 3 * PT_SEG + (16 * w + fr) * 64 + 32 + 8 * fq); \
        rab[0] = *(const u32x4*)(tb_ + 3 * PT_SEG + (16 * w + fr) * 64 + 8 * fq); rab[1] = *(const u32x4*)(tb_ + 3 * PT_SEG + (16 * w + fr) * 64 + 32 + 8 * fq); } while (0)
    for (int sg = F.bid; sg < NSEG; sg += F.G) {
        const int bh = sg >> 4, seg = sg & 15;
        f32x4 Rf[4][2], Rb[4][2];
#pragma unroll
        for (int gg = 0; gg < 4; ++gg)
#pragma unroll
            for (int n = 0; n < 2; ++n) { Rf[gg][n] = (f32x4){0.f, 0.f, 0.f, 0.f}; Rb[gg][n] = (f32x4){0.f, 0.f, 0.f, 0.f}; }
        float cumf = 0.f, cumb = 0.f;
        S1_LOAD(bh, NSEGC * seg, NSEGC * seg + NSEGC - 1);
#pragma unroll 1
        for (int i = 0; i < NSEGC; ++i) {
            const int cf = NSEGC * seg + i, cb = NSEGC * seg + NSEGC - 1 - i, par = i & 1;
            float lff[16], lfb[16];
            unpack_lf16(rlf, lff); unpack_lf16(rlb, lfb);
            const bf16x8 a0f = __builtin_bit_cast(bf16x8, raf[0]), a1f = __builtin_bit_cast(bf16x8, raf[1]), a0b = __builtin_bit_cast(bf16x8, rab[0]), a1b = __builtin_bit_cast(bf16x8, rab[1]);
#pragma unroll
            for (int dir = 1; dir < 2; ++dir) {
                bf16_t* Sd = F_S + (size_t)((bh * 2 + dir) * 256 + (dir ? cb : cf)) * 16384 + (size_t)(16 * w + fr) * 128 + 8 * fq;
#pragma unroll
                for (int gg = 0; gg < 4; ++gg) { const f32x4 r0 = dir ? Rb[gg][0] : Rf[gg][0], r1 = dir ? Rb[gg][1] : Rf[gg][1];
                    u32x4 o; o.x = cvt_pk_bf16(r0[0], r0[1]); o.y = cvt_pk_bf16(r0[2], r0[3]); o.z = cvt_pk_bf16(r1[0], r1[1]); o.w = cvt_pk_bf16(r1[2], r1[3]);
                    *(u32x4*)(Sd + 32 * gg) = o; }
            }
            if (i + 1 < NSEGC) S1_LOAD(bh, cf + 1, cb - 1);
            float tf = 0.f, tb = 0.f;
#pragma unroll
            for (int j = 0; j < 16; ++j) { tf += lff[j]; tb += lfb[j]; }
            float offF = 0.f, offB = 0.f, totf = 0.f, totb = 0.f;
#pragma unroll
            for (int q = 0; q < 4; ++q) { const float a = __shfl(tf, lq + q), bb = __shfl(tb, lq + q); totf += a; totb += bb; if (q > tq) offF += a; if (q < tq) offB += bb; }
            float kh[16];
            {
                float run = offF, ep = __builtin_amdgcn_exp2f(run);
#pragma unroll
                for (int j = 15; j >= 0; --j) { run += lff[j]; const float en = __builtin_amdgcn_exp2f(run); kh[j] = ep - en; ep = en; }
                LAS unsigned char* dst = lds + T_KT + (par * 2 + 0) * 128 * P64 + kr * P64 + tq * 32;
                *(LAS u32x4*)dst = pack8(kh); *(LAS u32x4*)(dst + 16) = pack8(kh + 8);
            }
            {
                float run = offB, ep = __builtin_amdgcn_exp2f(run);
#pragma unroll
                for (int j = 0; j < 16; ++j) { run += lfb[j]; const float en = __builtin_amdgcn_exp2f(run); kh[j] = ep - en; ep = en; }
                LAS unsigned char* dst = lds + T_KT + (par * 2 + 1) * 128 * P64 + kr * P64 + tq * 32;
                *(LAS u32x4*)dst = pack8(kh); *(LAS u32x4*)(dst + 16) = pack8(kh + 8);
            }
            LAS float* DL = (LAS float*)(lds + T_DL) + par * 256;
            if (tq == 0) { DL[k] = __builtin_amdgcn_exp2f(totf); }
            if (tq == 1) { F_DEC[(size_t)((bh * 2 + 1) * 256 + cb) * 128 + k] = __builtin_amdgcn_exp2f(cumb); DL[128 + k] = __builtin_amdgcn_exp2f(totb); }
            cumf += totf; cumb += totb;
            LBAR();
#pragma unroll
            for (int dir = 0; dir < 2; ++dir) {
                const LAS unsigned char* kt = lds + T_KT + (par * 2 + dir) * 128 * P64;
                const bf16x8 a0 = dir ? a0b : a0f, a1 = dir ? a1b : a1f;
#pragma unroll
                for (int gg = 0; gg < 4; ++gg) {
                    f32x4 r0 = dir ? Rb[gg][0] : Rf[gg][0], r1 = dir ? Rb[gg][1] : Rf[gg][1];
                    const f32x4 d0 = *(const LAS f32x4*)(DL + dir * 128 + 32 * gg + 8 * fq), d1 = *(const LAS f32x4*)(DL + dir * 128 + 32 * gg + 8 * fq + 4);
                    r0 = r0 * d0; r1 = r1 * d1;
                    r0 = MFMA16(a0, ldfrag(kt, P64, 32 * gg + fr, fq * 16), r0);
                    r1 = MFMA16(a0, ldfrag(kt, P64, 32 * gg + 16 + fr, fq * 16), r1);
                    r0 = MFMA16(a1, ldfrag(kt, P64, 32 * gg + fr, 64 + fq * 16), r0);
                    r1 = MFMA16(a1, ldfrag(kt, P64, 32 * gg + 16 + fr, 64 + fq * 16), r1);
                    if (dir) { Rb[gg][0] = r0; Rb[gg][1] = r1; } else { Rf[gg][0] = r0; Rf[gg][1] = r1; }
                }
            }
        }
#pragma unroll
        for (int dir = 0; dir < 2; ++dir) {
            bf16_t* Sd = F_SEG + (size_t)((bh * 2 + dir) * 16 + seg) * 16384 + (size_t)(16 * w + fr) * 128 + 8 * fq;
#pragma unroll
            for (int gg = 0; gg < 4; ++gg) { const f32x4 r0 = dir ? Rb[gg][0] : Rf[gg][0], r1 = dir ? Rb[gg][1] : Rf[gg][1];
                u32x4 o; o.x = cvt_pk_bf16(r0[0], r0[1]); o.y = cvt_pk_bf16(r0[2], r0[3]); o.z = cvt_pk_bf16(r1[0], r1[1]); o.w = cvt_pk_bf16(r1[2], r1[3]);
                *(u32x4*)(Sd + 32 * gg) = o; }
        }
        if (tq == 0) F_DSEG[(size_t)((bh * 2 + 0) * 16 + seg) * 128 + k] = __builtin_amdgcn_exp2f(cumf);
        if (tq == 1) F_DSEG[(size_t)((bh * 2 + 1) * 16 + seg) * 128 + k] = __builtin_amdgcn_exp2f(cumb);
        LBAR();
    }
#undef S1_LOAD
}

__device__ __forceinline__ void hgrn_s2(Frame& F) {
    PHASE_IDS();
    for (int e = F.bid * 512 + tid; e < 32 * 4096; e += F.G * 512) {
        const int stream = e >> 12, off = (e & 4095) * 4, dir = stream & 1;
        const bf16_t* Sg = F_SEG + (size_t)stream * 16 * 16384 + off; bf16_t* Cg = F_CARRY + (size_t)stream * 16 * 16384 + off; const float* Dg = F_DSEG + (size_t)stream * 16 * 128 + (off & 127);
        u32x2 loc[16]; f32x4 dd[16];
#pragma unroll
        for (int u = 0; u < 16; ++u) { const int sx = dir ? 15 - u : u; loc[u] = *(const u32x2*)(Sg + (size_t)sx * 16384); dd[u] = *(const f32x4*)(Dg + (size_t)sx * 128); }
        f32x4 run = {0.f, 0.f, 0.f, 0.f};
#pragma unroll
        for (int u = 0; u < 16; ++u) { const int sx = dir ? 15 - u : u;
            u32x2 o; o.x = cvt_pk_bf16(run[0], run[1]); o.y = cvt_pk_bf16(run[2], run[3]); *(u32x2*)(Cg + (size_t)sx * 16384) = o;
            run[0] = dd[u][0] * run[0] + bflo(loc[u].x); run[1] = dd[u][1] * run[1] + bfhi(loc[u].x); run[2] = dd[u][2] * run[2] + bflo(loc[u].y); run[3] = dd[u][3] * run[3] + bfhi(loc[u].y); }
    }
}

__device__ __forceinline__ u32x4 comb8(u32x4 sp, u32x4 cr, f32x4 d0, f32x4 d1) {
    u32x4 o;
    o.x = cvt_pk_bf16(bflo(sp.x) + d0[0] * bflo(cr.x), bfhi(sp.x) + d0[1] * bfhi(cr.x)); o.y = cvt_pk_bf16(bflo(sp.y) + d0[2] * bflo(cr.y), bfhi(sp.y) + d0[3] * bfhi(cr.y));
    o.z = cvt_pk_bf16(bflo(sp.z) + d1[0] * bflo(cr.z), bfhi(sp.z) + d1[1] * bfhi(cr.z)); o.w = cvt_pk_bf16(bflo(sp.w) + d1[2] * bflo(cr.w), bfhi(sp.w) + d1[3] * bfhi(cr.w));
    return o;
}
__device__ __forceinline__ void hgrn_s3(Frame& F) {
    LAS unsigned char* lds = F.lds;
    PHASE_IDS();
    const int k = tid >> 2, tq = tid & 3, w = wave, fr = lane & 15, fq = lane >> 4;
    const int tb = w & 3, half = w >> 2, lq = lane & ~3;
    LAS float* RSX = (LAS float*)(lds + H_RSX);
    const int NL = F.bid < NSEG ? ((NSEG - F.bid + F.G - 1) / F.G) * NSEGC : 0;
    u32x4 rq[2], rlf[2], rlb[2], rv[2], rsb[4], rcb[4]; f32x4 dcb[2];
    f32x4 Rf[4][2];
    const int kr = (k & ~31) + invperm32(k & 31), rrw = ((16 * w + fr) & ~31) + invperm32((16 * w + fr) & 31);
#define S3_DEC(L_, c_, bh_) const int sg_ = F.bid + ((L_) >> 4) * F.G; const int bh_ = sg_ >> 4, c_ = NSEGC * (sg_ & 15) + ((L_) & 15)
    const int pc8 = tid & 15;
#define S3_LOAD(it) do { S3_DEC(it, c_, bh_); const bf16_t* bp_ = F_PROJ + (size_t)((bh_ >> 3) * 256 + c_) * PT_CHUNK + (bh_ & 7) * PT_TILE; \
        _Pragma("unroll") for (int i_ = 0; i_ < 2; ++i_) { rq[i_] = *(const u32x4*)(bp_ + 0 * PT_SEG + k * 64 + 16 * tq + 8 * i_); rlf[i_] = *(const u32x4*)(bp_ + 1 * PT_SEG + k * 64 + 16 * tq + 8 * i_); rlb[i_] = *(const u32x4*)(bp_ + 2 * PT_SEG + k * 64 + 16 * tq + 8 * i_); \
            rv[i_] = *(const u32x4*)(bp_ + 3 * PT_SEG + (tid + 512 * i_) * 8); } } while (0)
#define S3_LOADS(it) do { S3_DEC(it, c_, bh_); const bf16_t* sb_ = F_S + (size_t)((bh_ * 2 + 1) * 256 + c_) * 16384 + tid * 8; \
        _Pragma("unroll") for (int i_ = 0; i_ < 4; ++i_) { rsb[i_] = *(const u32x4*)(sb_ + i_ * 4096); } \
        const float* db_ = F_DEC + (size_t)((bh_ * 2 + 1) * 256 + c_) * 128 + pc8 * 8; \
        dcb[0] = *(const f32x4*)db_; dcb[1] = *(const f32x4*)(db_ + 4); \
        if ((((it) & 15) == 0)) { const bf16_t* cb_ = F_CARRY + (size_t)((bh_ * 2 + 1) * 16 + (c_ >> 4)) * 16384 + tid * 8; \
            _Pragma("unroll") for (int i_ = 0; i_ < 4; ++i_) { rcb[i_] = *(const u32x4*)(cb_ + i_ * 4096); } } } while (0)
    if (NL > 0) { S3_LOAD(0); S3_LOADS(0); }
    f32x4 ogv[2][2];
#pragma unroll
    for (int i = 0; i < 2; ++i) { ogv[i][0] = *(const f32x4*)(F_onorm_g + 64 * half + 32 * i + 8 * fq); ogv[i][1] = *(const f32x4*)(F_onorm_g + 64 * half + 32 * i + 8 * fq + 4); }
    u32x4 po[2]; bf16_t* pop = nullptr;
#pragma unroll 1
    for (int L = 0; L < NL; ++L) {
        S3_DEC(L, c, bh); const int h = bh & 7, b = bh >> 3;
        const size_t row0 = (size_t)b * SEQ + 64 * c;
        const bool has_next = L + 1 < NL;
        if (L > 0) { *(u32x4*)pop = po[0]; *(u32x4*)(pop + 32) = po[1]; }
        if ((L & 15) == 0) {
            const bf16_t* cp = F_CARRY + (size_t)((bh * 2 + 0) * 16 + (c >> 4)) * 16384 + (size_t)(16 * w + fr) * 128 + 8 * fq;
#pragma unroll
            for (int gg = 0; gg < 4; ++gg) { const u32x4 cw = *(const u32x4*)(cp + 32 * gg); Rf[gg][0] = (f32x4){bflo(cw.x), bfhi(cw.x), bflo(cw.y), bfhi(cw.y)}; Rf[gg][1] = (f32x4){bflo(cw.z), bfhi(cw.z), bflo(cw.w), bfhi(cw.w)}; }
        }
        float lff[16], lfb[16], qv[16];
        unpack_lf16(rlf, lff); unpack_lf16(rlb, lfb);
#pragma unroll
        for (int q = 0; q < 2; ++q)
#pragma unroll
            for (int e = 0; e < 4; ++e) { qv[8 * q + 2 * e] = bflo(rq[q][e]); qv[8 * q + 2 * e + 1] = bfhi(rq[q][e]); }
#pragma unroll
        for (int i = 0; i < 2; ++i) { const int p = tid + 512 * i, d = p >> 3, c8 = p & 7, dr_ = (d & ~31) + invperm32(d & 31); *(LAS u32x4*)(lds + H_VT + dr_ * P64 + c8 * 16) = rv[i]; }
        if (has_next) S3_LOAD(L + 1);
        float offF = 0.f, offB = 0.f, offFs = 0.f, totf = 0.f;
        {
            float tf = 0.f, tbw = 0.f;
#pragma unroll
            for (int j = 0; j < 16; ++j) { tf += lff[j]; tbw += lfb[j]; }
#pragma unroll
            for (int q = 0; q < 4; ++q) { const float a_ = __shfl(tf, lq + q), b_ = __shfl(tbw, lq + q); totf += a_; if (q < tq) offF += a_; if (q > tq) { offB += b_; offFs += a_; } }
        }
        {
            float kh[16]; float run = offFs, ep = __builtin_amdgcn_exp2f(run);
#pragma unroll
            for (int j = 15; j >= 0; --j) { run += lff[j]; const float en = __builtin_amdgcn_exp2f(run); kh[j] = ep - en; ep = en; }
            LAS unsigned char* dst = lds + H_KTH + kr * P64 + tq * 32;
            *(LAS u32x4*)dst = pack8(kh); *(LAS u32x4*)(dst + 16) = pack8(kh + 8);
            if (tq == 0) ((LAS float*)(lds + H_DLF))[k] = __builtin_amdgcn_exp2f(totf);
#pragma unroll
            for (int gg = 0; gg < 4; ++gg) { const f32x4 r0 = Rf[gg][0], r1 = Rf[gg][1];
                u32x4 o; o.x = cvt_pk_bf16(r0[0], r0[1]); o.y = cvt_pk_bf16(r0[2], r0[3]); o.z = cvt_pk_bf16(r1[0], r1[1]); o.w = cvt_pk_bf16(r1[2], r1[3]);
                *(LAS u32x4*)(lds + H_SS + rrw * P128 + (32 * gg + 8 * fq) * 2) = o; }
        }
        {
            float run = offF, rp = __builtin_amdgcn_exp2f(-run);
            float runb = offB, rpb = __builtin_amdgcn_exp2f(-runb);
#pragma unroll
            for (int j = 0; j < 16; ++j) { run += lff[j]; const int t = 16 * tq + j; const float rn = __builtin_amdgcn_exp2f(-run);
                *(LAS bf16_t*)(lds + H_QT + t * P128 + k * 2) = (bf16_t)(cvt_pk_bf16(qv[j] * __builtin_amdgcn_exp2f(run), 0.f) & 0xffff);
                *(LAS bf16_t*)(lds + H_KT + t * P128 + k * 2) = (bf16_t)(cvt_pk_bf16(rn - rp, 0.f) & 0xffff); rp = rn;
                const int jb = 15 - j, tb_ = 16 * tq + jb; runb += lfb[jb]; const float rnb = __builtin_amdgcn_exp2f(-runb);
                *(LAS bf16_t*)(lds + H_QTB + tb_ * P128 + k * 2) = (bf16_t)(cvt_pk_bf16(qv[jb] * __builtin_amdgcn_exp2f(runb), 0.f) & 0xffff);
                *(LAS bf16_t*)(lds + H_KTB + tb_ * P128 + k * 2) = (bf16_t)(cvt_pk_bf16(rnb - rpb, 0.f) & 0xffff); rpb = rnb; }
        }
        LBAR();
        f32x4 oacc[4];
#pragma unroll
        for (int i = 0; i < 4; ++i) oacc[i] = (f32x4){0.f, 0.f, 0.f, 0.f};
        {
            f32x4 pf[2], pb[2];
#pragma unroll
            for (int i = 0; i < 2; ++i) { pf[i] = (f32x4){0.f, 0.f, 0.f, 0.f}; pb[i] = (f32x4){0.f, 0.f, 0.f, 0.f}; }
#pragma unroll
            for (int ks = 0; ks < 4; ++ks) {
                const bf16x8 a = ldfrag(lds + H_QT, P128, 16 * tb + fr, ks * 64 + fq * 16), ab = ldfrag(lds + H_QTB, P128, 16 * tb + fr, ks * 64 + fq * 16);
#pragma unroll
                for (int i = 0; i < 2; ++i) { pf[i] = MFMA16(a, ldfrag(lds + H_KT, P128, 16 * (2 * half + i) + fr, ks * 64 + fq * 16), pf[i]); pb[i] = MFMA16(ab, ldfrag(lds + H_KTB, P128, 16 * (2 * half + i) + fr, ks * 64 + fq * 16), pb[i]); }
#pragma unroll
                for (int i = 0; i < 4; ++i) oacc[i] = MFMA16(a, ldfrag(lds + H_SS, P128, 16 * (4 * half + i) + fr, ks * 64 + fq * 16), oacc[i]);
            }
            const int t = 16 * tb + fr;
#pragma unroll
            for (int i = 0; i < 2; ++i) { const int s0 = 16 * (2 * half + i) + 4 * fq; float pv[4];
#pragma unroll
                for (int j = 0; j < 4; ++j) { const int s_ = s0 + j; pv[j] = (s_ <= t ? pf[i][j] : 0.f) + (s_ >= t ? pb[i][j] : 0.f); }
                u32x2 o; o.x = cvt_pk_bf16(pv[0], pv[1]); o.y = cvt_pk_bf16(pv[2], pv[3]);
                *(LAS u32x2*)(lds + H_PB + t * P64 + s0 * 2) = o; }
        }
        {
            const bf16x8 a0 = ldfrag(lds + H_VT, P64, rrw, fq * 16), a1 = ldfrag(lds + H_VT, P64, rrw, 64 + fq * 16);
            const LAS float* DLF = (const LAS float*)(lds + H_DLF);
#pragma unroll
            for (int gg = 0; gg < 4; ++gg) {
                f32x4 r0 = Rf[gg][0], r1 = Rf[gg][1];
                const f32x4 d0 = *(const LAS f32x4*)(DLF + 32 * gg + 8 * fq), d1 = *(const LAS f32x4*)(DLF + 32 * gg + 8 * fq + 4);
                r0 = r0 * d0; r1 = r1 * d1;
                r0 = MFMA16(a0, ldfrag(lds + H_KTH, P64, 32 * gg + fr, fq * 16), r0);
                r1 = MFMA16(a0, ldfrag(lds + H_KTH, P64, 32 * gg + 16 + fr, fq * 16), r1);
                r0 = MFMA16(a1, ldfrag(lds + H_KTH, P64, 32 * gg + fr, 64 + fq * 16), r0);
                r1 = MFMA16(a1, ldfrag(lds + H_KTH, P64, 32 * gg + 16 + fr, 64 + fq * 16), r1);
                Rf[gg][0] = r0; Rf[gg][1] = r1;
            }
        }
        LBAR();
        u32x4 gw[2];
        {
#pragma unroll
            for (int i = 0; i < 4; ++i) { const int p = tid + 512 * i, r = p >> 4, cc = p & 15, rr = (r & ~31) + invperm32(r & 31); *(LAS u32x4*)(lds + H_SS + rr * P128 + cc * 16) = comb8(rsb[i], rcb[i], dcb[0], dcb[1]); }
            if (has_next) S3_LOADS(L + 1);
            const bf16_t* gp = F_PROJ + (size_t)(b * 256 + c) * PT_CHUNK + 4 * PT_SEG + h * PT_TILE + (16 * tb + fr) * 128 + 64 * half + 8 * fq;
#pragma unroll
            for (int i = 0; i < 2; ++i) gw[i] = *(const u32x4*)(gp + 32 * i);
        }
        LBAR();
#pragma unroll
        for (int ks = 0; ks < 4; ++ks) {
            const bf16x8 ab = ldfrag(lds + H_QTB, P128, 16 * tb + fr, ks * 64 + fq * 16);
#pragma unroll
            for (int i = 0; i < 4; ++i) oacc[i] = MFMA16(ab, ldfrag(lds + H_SS, P128, 16 * (4 * half + i) + fr, ks * 64 + fq * 16), oacc[i]);
        }
#pragma unroll
        for (int ks = 0; ks < 2; ++ks) {
            const bf16x8 a = ldfrag(lds + H_PB, P64, 16 * tb + fr, ks * 64 + fq * 16);
#pragma unroll
            for (int i = 0; i < 4; ++i) oacc[i] = MFMA16(a, ldfrag(lds + H_VT, P64, 16 * (4 * half + i) + fr, ks * 64 + fq * 16), oacc[i]);
        }
        {
            const int t = 16 * tb + fr;
            float ss = 0.f;
#pragma unroll
            for (int i = 0; i < 4; ++i) ss += (oacc[i][0] * oacc[i][0] + oacc[i][1] * oacc[i][1]) + (oacc[i][2] * oacc[i][2] + oacc[i][3] * oacc[i][3]);
            ss += __shfl_xor(ss, 16); ss += __shfl_xor(ss, 32);
            if (fq == 0) RSX[half * 64 + t] = ss;
            LBAR();
            const float rs = __builtin_amdgcn_rsqf((RSX[t] + RSX[64 + t]) * (1.0f / 128.0f) + EPS);
            bf16_t* op = F_CAT + (row0 + t) * DM + h * 128;
#pragma unroll
            for (int i = 0; i < 2; ++i) { const int d = 64 * half + 32 * i + 8 * fq;
                const f32x4 og0 = ogv[i][0], og1 = ogv[i][1]; (void)d;
                const f32x4 e0 = oacc[2 * i], e1 = oacc[2 * i + 1];
                u32x4 o; o.x = cvt_pk_bf16(e0[0] * rs * og0[0] * bflo(gw[i].x), e0[1] * rs * og0[1] * bfhi(gw[i].x));
                o.y = cvt_pk_bf16(e0[2] * rs * og0[2] * bflo(gw[i].y), e0[3] * rs * og0[3] * bfhi(gw[i].y));
                o.z = cvt_pk_bf16(e1[0] * rs * og1[0] * bflo(gw[i].z), e1[1] * rs * og1[1] * bfhi(gw[i].z));
                o.w = cvt_pk_bf16(e1[2] * rs * og1[2] * bflo(gw[i].w), e1[3] * rs * og1[3] * bfhi(gw[i].w));
                po[i] = o; }
            pop = op + 64 * half + 8 * fq;
        }
    }
    if (NL > 0) { *(u32x4*)pop = po[0]; *(u32x4*)(pop + 32) = po[1]; }
#undef S3_LOAD
#undef S3_LOADS
#undef S3_DEC
}

constexpr int G_RAW = 0, G_WL = 32768, G_VT = G_WL + 2 * 128 * P128, G_STAT = G_VT + 128 * P128;
static_assert(G_STAT + 1024 <= LDS_BYTES, "sgu lds");
__device__ __forceinline__ void sgu_phase(Frame& F) {
    LAS unsigned char* lds = F.lds;
    PHASE_IDS();
    const int d_e = tid & 127, sq = tid >> 7, w = wave, fr = lane & 15, fq = lane >> 4;
    LAS f32x2* STAT = (LAS f32x2*)(lds + G_STAT);
    const int dr = (d_e & ~31) + invperm32(d_e & 31);
    const float* vsum = F_ctl + CT_VSUM; const float* vssq = F_ctl + CT_VSSQ;
    u32x4 rvp[4], rw[4], uwn[4]; float lgn, lbn, bsn;
#define SGU_LOAD(r0_, g_) do { const bf16_t* vp_ = F_PROJ + (size_t)((r0_) >> 6) * PT_CHUNK + 6 * PT_SEG + (g_) * PT_TILE + (tid >> 4) * 128 + (tid & 15) * 8; const bf16_t* wp_ = F_SGUW + (size_t)(g_) * 16384 + tid * 8; \
        _Pragma("unroll") for (int i_ = 0; i_ < 4; ++i_) { rvp[i_] = *(const u32x4*)(vp_ + (size_t)(i_ >> 1) * PT_CHUNK + (i_ & 1) * 32 * 128); rw[i_] = *(const u32x4*)(wp_ + i_ * 4096); } \
        lgn = F_ln_g[(g_) * 128 + d_e]; lbn = F_ln_b[(g_) * 128 + d_e]; bsn = F_sgu_b[(g_) * 128 + 16 * w + fr]; \
        const bf16_t* up_ = F_PROJ + (size_t)(((r0_) >> 6) + (w >> 2)) * PT_CHUNK + 5 * PT_SEG + (g_) * PT_TILE + (16 * (w & 3) + fr) * 128 + 8 * fq; \
        _Pragma("unroll") for (int i_ = 0; i_ < 4; ++i_) uwn[i_] = *(const u32x4*)(up_ + 32 * i_); } while (0)
    for (int item = F.bid; item < M / 128; item += F.G) {
        const size_t r0 = (size_t)item * 128;
        SGU_LOAD(r0, 0);
        if (tid < 128) { const float mu = vsum[r0 + tid] * (1.0f / 1024.0f); const float var = vssq[r0 + tid] * (1.0f / 1024.0f) - mu * mu; STAT[tid] = (f32x2){mu, __builtin_amdgcn_rsqf(fmaxf(var, 0.f) + EPS)}; }
        const int t = 16 * w + fr;
        float ssq = 0.f;
#pragma unroll 1
        for (int g = 0; g < 8; ++g) {
            const int wl = G_WL + (g & 1) * 128 * P128;
            const float lg = lgn, lb = lbn, bs = bsn; u32x4 uw[4];
#pragma unroll
            for (int i = 0; i < 4; ++i) uw[i] = uwn[i];
#pragma unroll
            for (int i = 0; i < 4; ++i) { const int p = tid + 512 * i, r = p >> 4, cc = p & 15;
                *(LAS u32x4*)(lds + G_RAW + r * 256 + cc * 16) = rvp[i]; *(LAS u32x4*)(lds + wl + r * P128 + cc * 16) = rw[i]; }
            if (g < 7) SGU_LOAD(r0, g + 1);
            LBAR();
            {
#pragma unroll
                for (int i = 0; i < 4; ++i) { float y[8];
#pragma unroll
                    for (int j = 0; j < 8; ++j) { const int s_ = 32 * sq + 8 * i + j; const f32x2 st = STAT[s_]; y[j] = (bf2f(lds_u16(lds + G_RAW + s_ * 256 + d_e * 2)) - st[0]) * st[1] * lg + lb; }
                    *(LAS u32x4*)(lds + G_VT + dr * P128 + (32 * sq + 8 * i) * 2) = pack8(y); }
            }
            LBAR();
            bf16x8 a[4];
#pragma unroll
            for (int ks = 0; ks < 4; ++ks) a[ks] = ldfrag(lds + wl, P128, 16 * w + fr, ks * 64 + fq * 16);
            bf16_t* op = F_CAT + (r0 + t) * DM + 1024 + g * 128 + 8 * fq;
#pragma unroll
            for (int gg = 0; gg < 4; ++gg) {
                f32x4 acc0 = {0.f, 0.f, 0.f, 0.f}, acc1 = {0.f, 0.f, 0.f, 0.f};
#pragma unroll
                for (int ks = 0; ks < 4; ++ks) { acc0 = MFMA16(a[ks], ldfrag(lds + G_VT, P128, 32 * gg + fr, ks * 64 + fq * 16), acc0); acc1 = MFMA16(a[ks], ldfrag(lds + G_VT, P128, 32 * gg + 16 + fr, ks * 64 + fq * 16), acc1); }
                const u32x4 uq = uw[gg];
                const float v0 = bflo(uq.x) * (acc0[0] + bs), v1 = bfhi(uq.x) * (acc0[1] + bs), v2 = bflo(uq.y) * (acc0[2] + bs), v3 = bfhi(uq.y) * (acc0[3] + bs);
                const float v4 = bflo(uq.z) * (acc1[0] + bs), v5 = bfhi(uq.z) * (acc1[1] + bs), v6 = bflo(uq.w) * (acc1[2] + bs), v7 = bfhi(uq.w) * (acc1[3] + bs);
                ssq += (v0 * v0 + v1 * v1) + (v2 * v2 + v3 * v3) + (v4 * v4 + v5 * v5) + (v6 * v6 + v7 * v7);
                u32x4 o; o.x = cvt_pk_bf16(v0, v1); o.y = cvt_pk_bf16(v2, v3); o.z = cvt_pk_bf16(v4, v5); o.w = cvt_pk_bf16(v6, v7);
                *(u32x4*)(op + 32 * gg) = o;
            }
        }
        ssq += __shfl_xor(ssq, 16); ssq += __shfl_xor(ssq, 32);
        const float rs = __builtin_amdgcn_rsqf(ssq * (1.0f / 1024.0f) + EPS);
        asm volatile("s_waitcnt vmcnt(0)" ::: "memory");
#pragma unroll 1
        for (int gh = 0; gh < 2; ++gh) {
            bf16_t* op = F_CAT + (r0 + t) * DM + 1024 + gh * 512 + 8 * fq; const float* og = F_sgu_onorm + gh * 512 + 8 * fq;
            u32x4 vw[16];
#pragma unroll
            for (int q = 0; q < 16; ++q) vw[q] = *(const u32x4*)(op + 32 * q);
#pragma unroll
            for (int q = 0; q < 16; ++q) { const f32x4 o4 = *(const f32x4*)(og + 32 * q), o5 = *(const f32x4*)(og + 32 * q + 4);
                u32x4 o; o.x = cvt_pk_bf16(bflo(vw[q].x) * rs * o4[0], bfhi(vw[q].x) * rs * o4[1]); o.y = cvt_pk_bf16(bflo(vw[q].y) * rs * o4[2], bfhi(vw[q].y) * rs * o4[3]);
                o.z = cvt_pk_bf16(bflo(vw[q].z) * rs * o5[0], bfhi(vw[q].z) * rs * o5[1]); o.w = cvt_pk_bf16(bflo(vw[q].w) * rs * o5[2], bfhi(vw[q].w) * rs * o5[3]);
                *(u32x4*)(op + 32 * q) = o; }
        }
        LBAR();
    }
#undef SGU_LOAD
}

__device__ __forceinline__ void final_norm(Frame& F) {
    PHASE_IDS();
    const int gw = F.bid * 8 + wave, NGW = F.G * 8;
    const float* ssq = F_ctl + CT_SSQ3;
    f32x4 gv[8];
#pragma unroll
    for (int j = 0; j < 8; ++j) gv[j] = *((const f32x4*)F_final_g + lane + 64 * j);
    for (int m = gw; m < M; m += 2 * NGW) {
        const int m2 = (m + NGW < M) ? m + NGW : m;
        const float rs = __builtin_amdgcn_rsqf(ssq[m] * (1.0f / DM) + EPS), rs2 = __builtin_amdgcn_rsqf(ssq[m2] * (1.0f / DM) + EPS);
        const u32x2* hr = (const u32x2*)(F_H3B + (size_t)m * DM) + lane; const u32x2* hr2 = (const u32x2*)(F_H3B + (size_t)m2 * DM) + lane;
        f32x4* xr = (f32x4*)(F.out + (size_t)m * DM) + lane; f32x4* xr2 = (f32x4*)(F.out + (size_t)m2 * DM) + lane;
        u32x2 hv[8], hv2[8];
#pragma unroll
        for (int j = 0; j < 8; ++j) { hv[j] = hr[64 * j]; hv2[j] = hr2[64 * j]; }
#pragma unroll
        for (int j = 0; j < 8; ++j) { f32x4 v = {bflo(hv[j].x), bfhi(hv[j].x), bflo(hv[j].y), bfhi(hv[j].y)}; v = v * rs * gv[j]; xr[64 * j] = v;
            f32x4 v2 = {bflo(hv2[j].x), bfhi(hv2[j].x), bflo(hv2[j].y), bfhi(hv2[j].y)}; v2 = v2 * rs2 * gv[j]; xr2[64 * j] = v2; }
    }
}

#define XB_TMO      128
#define XB_XCNT(j)  (256  + 64 * (j))
#define XB_XSUB(j)  (1280 + 64 * (j))
#define XB_XGEN(j)  (2304 + 64 * (j))
#define XB_TOP      3328
#define XB_TOPGEN   3392
#define XCD_BAR_WORDS 3456
#define XB_SPIN_CAP (1u << 18)

__device__ __forceinline__ unsigned xb_ld(unsigned* p)              { return __hip_atomic_load(p, __ATOMIC_RELAXED, __HIP_MEMORY_SCOPE_AGENT); }
__device__ __forceinline__ unsigned xb_add(unsigned* p, unsigned v) { return __hip_atomic_fetch_add(p, v, __ATOMIC_RELAXED, __HIP_MEMORY_SCOPE_AGENT); }
__device__ __forceinline__ unsigned xb_xcc_id() { return (unsigned)__builtin_amdgcn_s_getreg((3 << 11) | 20) & 0xFu; }
#define XB_SPIN(cond, bar) do { unsigned _sp = 0; while (cond) { __builtin_amdgcn_s_sleep(1); \
    if ((++_sp & 255u) == 0u) { if (xb_ld(&(bar)[XB_TMO])) break; if (_sp > XB_SPIN_CAP) { atomicAdd(&(bar)[XB_TMO], 1u); break; } } } } while (0)

struct XcdBarrier {
    unsigned* bar; unsigned x;
    volatile LAS unsigned* st;
};

__device__ __forceinline__ XcdBarrier xcd_barrier_post(unsigned* bar, volatile LAS unsigned* st) {
    XcdBarrier b; b.bar = bar; b.x = xb_xcc_id(); b.st = st;
    if (threadIdx.x == 0) (void)xb_add(&bar[XB_XCNT(b.x)], 1u);
    return b;
}
__device__ __forceinline__ void xcd_barrier_complete(unsigned* bar, unsigned x, unsigned& nloc, unsigned& nx) {
    const unsigned G = gridDim.x * gridDim.y * gridDim.z;
    unsigned sum, cnt, mine, sp = 0u;
    for (;;) {
        sum = 0u; cnt = 0u; mine = 0u;
#pragma unroll
        for (unsigned j = 0; j < 16; ++j) { const unsigned c = xb_ld(&bar[XB_XCNT(j)]); sum += c; cnt += (c > 0u) ? 1u : 0u; mine = (j == x) ? c : mine; }
        if (sum == G) break;
        __builtin_amdgcn_s_sleep(1);
        if ((++sp & 255u) == 0u) { if (xb_ld(&bar[XB_TMO])) break; if (sp > XB_SPIN_CAP) { atomicAdd(&bar[XB_TMO], 1u); break; } }
    }
    nloc = mine > 0u ? mine : 1u; nx = cnt > 0u ? cnt : 1u;
}

__device__ __forceinline__ void xcd_barrier(const XcdBarrier& b) {
    asm volatile("s_waitcnt vmcnt(0)" ::: "memory");
    __syncthreads();
    if (threadIdx.x == 0) {
        unsigned* bar = b.bar;
        __builtin_amdgcn_s_waitcnt(0);
        unsigned nloc = b.st[0], nx = b.st[1];
        if (nloc == 0u) { xcd_barrier_complete(bar, b.x, nloc, nx); b.st[0] = nloc; b.st[1] = nx; }
        const unsigned old = xb_add(&bar[XB_XSUB(b.x)], 1u);
        const unsigned gen = old / nloc;
        if (old + 1u == (gen + 1u) * nloc) {
            __builtin_amdgcn_fence(__ATOMIC_RELEASE, "agent");
            asm volatile("s_waitcnt vmcnt(0)" ::: "memory");
            const unsigned og = xb_add(&bar[XB_TOP], 1u);
            const unsigned tg = og / nx;
            if (og + 1u == (tg + 1u) * nx) xb_add(&bar[XB_TOPGEN], 1u);
            else XB_SPIN(xb_ld(&bar[XB_TOPGEN]) == tg, bar);
            __builtin_amdgcn_fence(__ATOMIC_ACQUIRE, "agent");
            xb_add(&bar[XB_XGEN(b.x)], 1u);
            asm volatile("s_waitcnt vmcnt(0)" ::: "memory");
        } else {
            XB_SPIN(xb_ld(&bar[XB_XGEN(b.x)]) == gen, bar);
            __builtin_amdgcn_fence(__ATOMIC_ACQUIRE, "agent");
            asm volatile("s_waitcnt vmcnt(0)" ::: "memory");
        }
    }
    __syncthreads();
}


constexpr int N_PHASES = 10;
__global__ void __launch_bounds__(512) mk_fwd(Args args) {
    extern __shared__ __attribute__((aligned(16))) unsigned char lds_raw[];
    Frame F;
    F.lds = (LAS unsigned char*)lds_raw;
    F.G = gridDim.x; F.bid = blockIdx.x;
    F.in = args.in; F.out = args.out; F.ws = args.ws;
    cg::grid_group grid = cg::this_grid();
    volatile LAS unsigned* bst = (volatile LAS unsigned*)(F.lds + LDS_BARST);
    if (threadIdx.x < 2) bst[threadIdx.x] = 0u;
    __syncthreads();
    const XcdBarrier bar = xcd_barrier_post((unsigned*)(args.ws + WS_BAR), bst);
    const int lo = args.ph_lo, hi = args.ph_hi;
#define IN(k) (lo <= (k) && (k) < hi)
#define SEAM(k) do { if (IN(k) && IN((k) + 1)) xcd_barrier(bar); } while (0)
    if (lo < 0) grid.sync();

    if (IN(0)) { p0_prologue(F); }
    SEAM(0);
    if (IN(1)) {
        { pg8::Gemm g{F_WIN, F_HB, 4096, M, DM}; pg8::StaticOrder S; S.init(4096, M, F.G, F.bid);
          EpiInT E{F_PROJ, F_ctl + CT_LBF, F_ctl + CT_LBB};
          pg8::gemm_phase<EpiInT, pg8::StaticOrder>(F.lds, g, S, E); }
        { pg8::Gemm g{F_HB, F_WIN + (size_t)4096 * DM, M, INC - 4096, DM}; pg8::StaticOrder S; S.init(M, INC - 4096, F.G, F.bid);
          EpiIn E{F_PROJ, F_ctl + CT_LBF, F_ctl + CT_LBB, F_ctl + CT_VSUM, F_ctl + CT_VSSQ, 4};
          pg8::gemm_phase<EpiIn, pg8::StaticOrder>(F.lds, g, S, E); }
    }
    SEAM(1);
    if (IN(2)) { hgrn_s1(F); __syncthreads(); sgu_phase(F); }
    SEAM(2);
    if (IN(3)) { hgrn_s2(F); }
    SEAM(3);
    if (IN(4)) { hgrn_s3(F); }
    SEAM(4);
    if (IN(5)) {
        pg8::Gemm g{F_CAT, F_WOUT, M, DM, DM}; pg8::StaticOrder S; S.init(M, DM, F.G, F.bid);
        EpiRes<false> E{F_x, F_HB, F_ctl + CT_SSQ1};
        pg8::gemm_phase<EpiRes<false>, pg8::StaticOrder>(F.lds, g, S, E);
    }
    SEAM(5);
    if (IN(6)) {
        { pg8::Gemm g{F_HB, F_WGU, M, 2 * FF, DM}; pg8::StaticOrder S; S.init(M, 2 * FF, F.G, F.bid);
          EpiGU E{F_ACT, F_ctl + CT_SSQ1};
          pg8::gemm_phase<EpiGU, pg8::StaticOrder>(F.lds, g, S, E); }
        { pg8::Gemm g{F_PBF, F_WPP, M, DM, PLE}; pg8::StaticOrder S; S.init(M, DM, F.G, F.bid);
          EpiPP E{F_PP};
          pg8::gemm_phase<EpiPP, pg8::StaticOrder>(F.lds, g, S, E); }
    }
    SEAM(6);
    if (IN(7)) {
        pg8::Gemm g{F_ACT, F_WDN, M, DM, FF}; pg8::StaticOrder S; S.init(M, DM, F.G, F.bid);
        EpiRes<true> E{nullptr, F_HB, F_ctl + CT_SSQ2};
        pg8::gemm_phase<EpiRes<true>, pg8::StaticOrder>(F.lds, g, S, E);
    }
    SEAM(7);
    if (IN(8)) {
        pg8::Gemm g{F_HB, F_WPG, M, DM, DM}; pg8::StaticOrder S; S.init(M, DM, F.G, F.bid);
        EpiPle E{F_HB, F_H3B, F_PP, F_ctl + CT_SSQ2, F_ctl + CT_SSQ3};
        pg8::gemm_phase<EpiPle, pg8::StaticOrder>(F.lds, g, S, E);
    }
    SEAM(8);
    if (IN(9)) { final_norm(F); }
#undef IN
#undef SEAM
}

extern "C" void kernel_launch(void* const* d_in, const int* in_sizes, int n_in, void* d_out, int out_size, void* d_ws, size_t ws_size, hipStream_t stream) {
    static int grid = 0;
    if (grid == 0) {
        if (n_in != 21 || out_size != M * DM || ws_size < WS_END) { fprintf(stderr, "kernel_launch: unexpected sizes n_in %d out %d ws %zu\n", n_in, out_size, ws_size); grid = -1; return; }
        int dev = 0, cus = 0, per_cu = 0;
        hipGetDevice(&dev); hipDeviceGetAttribute(&cus, hipDeviceAttributeMultiprocessorCount, dev);
        if (hipFuncSetAttribute((const void*)mk_fwd, hipFuncAttributeMaxDynamicSharedMemorySize, LDS_BYTES) != hipSuccess) { fprintf(stderr, "kernel_launch: hipFuncSetAttribute failed\n"); grid = -1; return; }
        if (hipOccupancyMaxActiveBlocksPerMultiprocessor(&per_cu, (const void*)mk_fwd, 512, LDS_BYTES) != hipSuccess || per_cu < 1) { fprintf(stderr, "kernel_launch: occupancy query gave %d\n", per_cu); per_cu = 1; }
        (void)hipGetLastError();
        grid = cus * 1;
        fprintf(stderr, "kernel_launch: cus %d per_cu %d grid %d\n", cus, per_cu, grid);
    }
    if (grid < 0) return;
    if (hipMemsetAsync((char*)d_ws + WS_BAR, 0, XCD_BAR_WORDS * 4, stream) != hipSuccess) { fprintf(stderr, "kernel_launch: memset of barrier words failed\n"); return; }
    Args a{};
    for (int i = 0; i < 21; ++i) a.in[i] = (const float*)d_in[i];
    a.out = (float*)d_out; a.ws = (unsigned char*)d_ws;
#if MK_N_LAUNCHES == 1
    a.ph_lo = 0; a.ph_hi = N_PHASES;
    void* kargs[] = {&a};
    hipError_t e = hipLaunchCooperativeKernel((const void*)mk_fwd, dim3(grid), dim3(512), kargs, LDS_BYTES, stream);
    if (e != hipSuccess) fprintf(stderr, "kernel_launch: cooperative launch failed: %s (grid %d)\n", hipGetErrorString(e), grid);
#else
    for (int ph = 0; ph < N_PHASES; ++ph) {
        a.ph_lo = ph; a.ph_hi = ph + 1;
        void* kargs[] = {&a};
        hipError_t e = hipLaunchCooperativeKernel((const void*)mk_fwd, dim3(grid), dim3(512), kargs, LDS_BYTES, stream);
        if (e != hipSuccess) { fprintf(stderr, "kernel_launch: launch %d failed: %s (grid %d)\n", ph, hipGetErrorString(e), grid); break; }
    }
#endif
}
```

```cpp
#include <hip/hip_runtime.h>
#include <hip/hip_cooperative_groups.h>
#include <cstdio>
#include <cstdint>
namespace cg = cooperative_groups;

#ifndef MK_N_LAUNCHES
#define MK_N_LAUNCHES 1
#endif

#define LAS __attribute__((address_space(3)))
typedef unsigned short bf16_t;
typedef short bf16x8 __attribute__((ext_vector_type(8)));
typedef float f32x4 __attribute__((ext_vector_type(4)));
typedef float f32x2 __attribute__((ext_vector_type(2)));
typedef unsigned u32x4 __attribute__((ext_vector_type(4)));
typedef unsigned u32x2 __attribute__((ext_vector_type(2)));

constexpr int BATCH = 2, SEQ = 16384, M = BATCH * SEQ, DM = 2048, INC = 7168, FF = 5632, PLE = 256;
constexpr int NHEAD = 8, NCHUNK = SEQ / 64;
constexpr float EPS = 1e-6f;
constexpr int C_Q = 0, C_ZF = 1024, C_ZB = 2048, C_I = 3072, C_G = 4096, C_U = 5120, C_V = 6144;
constexpr size_t PT_TILE = 8192, PT_SEG = 8 * PT_TILE, PT_CHUNK = 7 * PT_SEG;

constexpr size_t MiB = 1u << 20;
constexpr size_t WS_CTL = 0;
constexpr size_t WS_WIN = 1 * MiB, WS_WOUT = 29 * MiB, WS_WGU = 37 * MiB, WS_WDN = 81 * MiB, WS_WPG = 103 * MiB, WS_WPP = 111 * MiB, WS_SGUW = 112 * MiB;
constexpr size_t WS_PBF = 113 * MiB, WS_DEC = 129 * MiB, WS_PROJ = 133 * MiB, WS_CAT = 581 * MiB, WS_HB = 709 * MiB, WS_SEG = 965 * MiB, WS_CARRY = 981 * MiB, WS_DSEG = 997 * MiB, WS_END = 998 * MiB;
constexpr size_t WS_ACT = WS_PROJ, WS_PP = WS_CAT, WS_S = WS_HB;
constexpr int CT_LBF = 0, CT_LBB = 1024, CT_VSUM = 16384, CT_VSSQ = CT_VSUM + M, CT_SSQ1 = CT_VSSQ + M, CT_SSQ2 = CT_SSQ1 + M, CT_SSQ3 = CT_SSQ2 + M;
static_assert((size_t)(CT_SSQ3 + M) * 4 <= 1 * MiB, "ctl");

constexpr int LDS_BYTES = 163840;
constexpr size_t WS_BAR = 768 * 1024;
constexpr int LDS_BARST = 163584;

typedef __bf16 bf16v2 __attribute__((ext_vector_type(2)));
__device__ __forceinline__ unsigned cvt_pk_bf16(float lo, float hi) { const f32x2 v = {lo, hi}; const bf16v2 r = __builtin_convertvector(v, bf16v2); return __builtin_bit_cast(unsigned, r); }
__device__ __forceinline__ float bf2f(unsigned short h) { return __uint_as_float((unsigned)h << 16); }
__device__ __forceinline__ float bflo(unsigned w) { return __uint_as_float(w << 16); }
__device__ __forceinline__ float bfhi(unsigned w) { return __uint_as_float(w & 0xffff0000u); }
__device__ __forceinline__ float h2f(unsigned short h) { return (float)__builtin_bit_cast(_Float16, h); }
__device__ __forceinline__ unsigned short f2h(float f) { return __builtin_bit_cast(unsigned short, (_Float16)f); }
__device__ __forceinline__ float fsigmoid(float x) { return __builtin_amdgcn_rcpf(1.0f + __expf(-x)); }
__device__ __forceinline__ float fsilu(float x) { return x * fsigmoid(x); }
__device__ __forceinline__ float wave_sum(float v) {
#pragma unroll
    for (int o = 1; o < 64; o <<= 1) v += __shfl_xor(v, o);
    return v;
}
__device__ __forceinline__ void atomic_addf(float* p, float v) { __hip_atomic_fetch_add(p, v, __ATOMIC_RELAXED, __HIP_MEMORY_SCOPE_AGENT); }
__device__ __forceinline__ float gelu1(float v) {
    const float av = __builtin_fabsf(v), t = __builtin_amdgcn_rcpf(av * 0.2316418882f + 1.0f);
    float q = t * 0.5307027145f + (-0.7265760135f); q = q * t + 0.7107068705f; q = q * t + (-0.142248368f); q = q * t + 0.127414796f; q = q * t;
    const float e = __builtin_amdgcn_exp2f((v * v) * (-0.72134752044f));
    const float m = v * (q * e);
    return v < 0.f ? m : v - m;
}

__device__ __forceinline__ int fresh_tid();
typedef _Float16 f16v2 __attribute__((ext_vector_type(2)));
__device__ __forceinline__ f32x2 exp2_pk(f32x2 v) { f32x2 r; r.x = __builtin_amdgcn_exp2f(v.x); r.y = __builtin_amdgcn_exp2f(v.y); return r; }
__device__ __forceinline__ f32x2 rcp_pk(f32x2 v) { f32x2 r; r.x = __builtin_amdgcn_rcpf(v.x); r.y = __builtin_amdgcn_rcpf(v.y); return r; }
__device__ __forceinline__ f32x2 log2_pk(f32x2 v) { f32x2 r; r.x = __builtin_amdgcn_logf(v.x); r.y = __builtin_amdgcn_logf(v.y); return r; }
__device__ __forceinline__ f32x2 sigmoid_pk(f32x2 x) { return rcp_pk(exp2_pk(x * (-1.4426950408889634f)) + 1.0f); }
__device__ __forceinline__ f32x2 silu_pk(f32x2 x) { return x * sigmoid_pk(x); }
__device__ __forceinline__ f32x2 gelu_pk(f32x2 v) {
    const f32x2 av = __builtin_elementwise_abs(v), d = av * 0.2316418882f + 1.0f;
    const f32x2 t = rcp_pk(d);
    f32x2 q = t * 0.5307027145f + (-0.7265760135f); q = q * t + 0.7107068705f; q = q * t + (-0.142248368f); q = q * t + 0.127414796f; q = q * t;
    const f32x2 e = exp2_pk((v * v) * (-0.72134752044f));
    const f32x2 m = v * (q * e), r = v - m;
    f32x2 o; o.x = v.x < 0.f ? m.x : r.x; o.y = v.y < 0.f ? m.y : r.y; return o;
}
__device__ __forceinline__ unsigned cvt_pk_bf16v(f32x2 v) { const bf16v2 r = __builtin_convertvector(v, bf16v2); return __builtin_bit_cast(unsigned, r); }
__device__ __forceinline__ unsigned cvt_pk_f16v(f32x2 v) { const f16v2 r = __builtin_convertvector(v, f16v2); return __builtin_bit_cast(unsigned, r); }
namespace pg8 {
constexpr int BM = 256, BK = 64, HALF = 128, HTB = HALF * BK * 2, STAGE_BYTES = 8 * HTB, NXCD = 8, WGM = 4;
__host__ __device__ __forceinline__ int lds_byte(int r, int c) { const int st = (r >> 4) * 2 + (c >> 5), rr = r & 15, cc = c & 31, ob = rr * 64 + cc * 2; return st * 1024 + (ob ^ (((ob >> 9) & 1) << 5)); }
__host__ __device__ __forceinline__ void stage_rc(int b, int& R, int& C) { const int st = b / 1024, sb = b % 1024, swz = sb ^ (((sb >> 9) & 1) << 5); R = (st >> 1) * 16 + swz / 64; C = (st & 1) * 32 + (swz % 64) / 2; }
__host__ __device__ __forceinline__ int perm32(int rho) { const int n = rho >> 4, i = rho & 15; return 8 * (i >> 2) + 4 * n + (i & 3); }

struct Unit { int pm, pn; };
struct Gemm { const bf16_t* A; const bf16_t* Bt; int M, N, K; };

struct StaticOrder {
    int nM, nN, nwg, G, c;
    __host__ __device__ __forceinline__ void init(int M_, int N_, int G_, int c_) { nM = M_ / BM; nN = N_ / BM; nwg = nM * nN; G = G_; c = c_; }
    __host__ __device__ __forceinline__ bool next(int i, Unit& u) const {
        const long L = (long)i * G + c; if (L >= nwg) return false;
        int wgid = (int)L; { const int q = nwg / NXCD, r = nwg % NXCD, xcd = wgid % NXCD, off = wgid / NXCD; wgid = (xcd < r ? xcd * (q + 1) : r * (q + 1) + (xcd - r) * q) + off; }
        const int nig = WGM * nN, gid = wgid / nig, fm = gid * WGM, gsz = (nM - fm) < WGM ? (nM - fm) : WGM;
        u.pm = fm + ((wgid % nig) % gsz); u.pn = (wgid % nig) / gsz; return true;
    }
};

typedef f32x4 Acc[2][2][4][2];

template <class Epi, class Sched, bool ALIGN_EPI = true>
__device__ __forceinline__ void gemm_phase(LAS unsigned char* lds, const Gemm g, const Sched& S, const Epi& E) {
    const int tid = fresh_tid(), wid = __builtin_amdgcn_readfirstlane(tid >> 6), lane = tid & 63, wr = wid >> 2, wc = wid & 3, fr = lane & 15, fq = lane >> 4;
    const int K = g.K, nt = K / BK;
    unsigned voffA[2], voffB[2];
#pragma unroll
    for (int i = 0; i < 2; ++i) { int R, C; stage_rc(tid * 16 + i * 8192, R, C); const int Rb = Epi::PERM ? ((R & ~31) + perm32(R & 31)) : R;
        voffA[i] = (unsigned)(R * K + C) * 2u; voffB[i] = (unsigned)(Rb * K + C) * 2u; }
    const size_t kstep = (size_t)(BK * 2);
    const size_t hstep = (size_t)HALF * K * 2;
    const size_t tstep = 2 * hstep;
    const unsigned ldsw = (unsigned)wid * 1024u;
    const int aoff = lds_byte(wr * 64 + fr, fq * 8), boff = lds_byte(wc * 32 + fr, fq * 8);
#define PG8_SA(b, h) (((b) * 2 + (h)) * HTB)
#define PG8_SB(b, h) ((4 + (b) * 2 + (h)) * HTB)
#define PG8_STAGE(bufoff, gbase, voff) do { _Pragma("unroll") for (int _i = 0; _i < 2; ++_i) \
        __builtin_amdgcn_global_load_lds((const unsigned*)((const char*)(gbase) + (voff)[_i]), (LAS unsigned*)(lds + (bufoff) + ldsw + _i * 8192), 16, 0, 0); } while (0)
#define PG8_LDA(dst, b, h) do { _Pragma("unroll") for (int m = 0; m < 4; ++m) _Pragma("unroll") for (int k = 0; k < 2; ++k) dst[m][k] = *(const LAS bf16x8*)(lds + PG8_SA(b, h) + aoff + m * 2048 + k * 1024); } while (0)
#define PG8_LDB(dst, b, h) do { _Pragma("unroll") for (int n = 0; n < 2; ++n) _Pragma("unroll") for (int k = 0; k < 2; ++k) dst[n][k] = *(const LAS bf16x8*)(lds + PG8_SB(b, h) + boff + n * 2048 + k * 1024); } while (0)
#define PG8_MMA(ai, bj, At, Bt) do { __builtin_amdgcn_s_setprio(1); _Pragma("unroll") for (int m = 0; m < 4; ++m) _Pragma("unroll") for (int n = 0; n < 2; ++n) _Pragma("unroll") for (int k = 0; k < 2; ++k) \
        acc[ai][bj][m][n] = __builtin_amdgcn_mfma_f32_16x16x32_bf16(Bt[n][k], At[m][k], acc[ai][bj][m][n], 0, 0, 0); __builtin_amdgcn_s_setprio(0); } while (0)
#define PG8_WAIT_V(n) asm volatile("s_waitcnt vmcnt(" #n ")" ::: "memory")
#define PG8_WAIT_L(n) asm volatile("s_waitcnt lgkmcnt(" #n ")" ::: "memory")
#define PG8_BAR __builtin_amdgcn_s_barrier()
#define PG8_SCHED __builtin_amdgcn_sched_barrier(0)
    int tab_pm = -1, tab_pn = 0;
    { Unit uu; if (S.next(lane, uu)) { tab_pm = uu.pm; tab_pn = uu.pn; } }
#define PG8_NEXT(i, u) ((u).pm = __builtin_amdgcn_readlane(tab_pm, (i)), (u).pn = __builtin_amdgcn_readlane(tab_pn, (i)), (u).pm >= 0)
    Unit cur, nxt; int ui = 0;
    if (!PG8_NEXT(0, cur)) return;
    Acc acc;
#pragma unroll
    for (int a = 0; a < 2; ++a)
#pragma unroll
        for (int b = 0; b < 2; ++b)
#pragma unroll
            for (int m = 0; m < 4; ++m)
#pragma unroll
                for (int n = 0; n < 2; ++n) acc[a][b][m][n] = (f32x4){0.f, 0.f, 0.f, 0.f};
    bf16x8 At[4][2], B0[2][2], B1[2][2];
    const char* cA = (const char*)g.A + (size_t)cur.pm * tstep; const char* cB = (const char*)g.Bt + (size_t)cur.pn * tstep;
    PG8_STAGE(PG8_SB(0, 0), cB, voffB); PG8_STAGE(PG8_SB(0, 1), cB + hstep, voffB); PG8_STAGE(PG8_SA(0, 0), cA, voffA); PG8_STAGE(PG8_SA(0, 1), cA + hstep, voffA);
    if (wr == 1) PG8_BAR;
    PG8_WAIT_V(2); PG8_BAR;
    PG8_STAGE(PG8_SB(1, 0), cB + kstep, voffB); PG8_STAGE(PG8_SA(1, 0), cA + kstep, voffA); PG8_STAGE(PG8_SB(1, 1), cB + hstep + kstep, voffB);
    PG8_WAIT_V(6); PG8_BAR;
    for (;;) {
        const bool has_next = PG8_NEXT(ui + 1, nxt);
        const char* nA = has_next ? (const char*)g.A + (size_t)nxt.pm * tstep : cA; const char* nB = has_next ? (const char*)g.Bt + (size_t)nxt.pn * tstep : cB;
        for (int t = 0; t < nt; t += 2) {
            const bool last = (t == nt - 2);
            const char* a1 = cA + (size_t)(t + 1) * kstep;
            const char* a2 = last ? nA : cA + (size_t)(t + 2) * kstep; const char* b2 = last ? nB : cB + (size_t)(t + 2) * kstep;
            const char* a3 = a2 + kstep; const char* b3 = b2 + kstep;
            PG8_LDB(B0, 0, 0); PG8_LDB(B1, 0, 1); PG8_SCHED; PG8_LDA(At, 0, 0); PG8_STAGE(PG8_SA(1, 1), a1 + hstep, voffA);
            PG8_WAIT_V(8); PG8_WAIT_L(0); PG8_BAR; PG8_MMA(0, 0, At, B0); PG8_MMA(0, 1, At, B1); PG8_BAR; PG8_SCHED;
            PG8_LDA(At, 0, 1); PG8_STAGE(PG8_SB(0, 0), b2, voffB); PG8_STAGE(PG8_SB(0, 1), b2 + hstep, voffB); PG8_STAGE(PG8_SA(0, 0), a2, voffA);
            PG8_WAIT_V(8); PG8_WAIT_L(0); PG8_BAR; PG8_MMA(1, 0, At, B0); PG8_MMA(1, 1, At, B1); PG8_BAR; PG8_SCHED;
            PG8_LDB(B0, 1, 0); PG8_LDB(B1, 1, 1); PG8_SCHED; PG8_LDA(At, 1, 0); PG8_STAGE(PG8_SA(0, 1), a2 + hstep, voffA);
            PG8_WAIT_V(8); PG8_WAIT_L(0); PG8_BAR; PG8_MMA(0, 0, At, B0); PG8_MMA(0, 1, At, B1); PG8_BAR; PG8_SCHED;
            PG8_LDA(At, 1, 1); PG8_STAGE(PG8_SB(1, 0), b3, voffB); PG8_STAGE(PG8_SB(1, 1), b3 + hstep, voffB); PG8_STAGE(PG8_SA(1, 0), a3, voffA);
            PG8_WAIT_V(8); PG8_WAIT_L(0); PG8_BAR; PG8_MMA(1, 0, At, B0); PG8_MMA(1, 1, At, B1); PG8_BAR; PG8_SCHED;
        }
        if constexpr (ALIGN_EPI) { if (wr == 0) PG8_BAR; }
        E(acc, cur, wr, wc, fr, fq);
        if (!has_next) break;
#pragma unroll
        for (int a = 0; a < 2; ++a)
#pragma unroll
            for (int b = 0; b < 2; ++b)
#pragma unroll
                for (int m = 0; m < 4; ++m)
#pragma unroll
                    for (int n = 0; n < 2; ++n) acc[a][b][m][n] = (f32x4){0.f, 0.f, 0.f, 0.f};
        cur = nxt; cA = nA; cB = nB; ++ui;
        if constexpr (ALIGN_EPI) { if (wr == 1) PG8_BAR; }
    }
    PG8_WAIT_V(0);
    if constexpr (!ALIGN_EPI) { if (wr == 0) PG8_BAR; }
    PG8_BAR;
#undef PG8_SA
#undef PG8_SB
#undef PG8_STAGE
#undef PG8_LDA
#undef PG8_LDB
#undef PG8_MMA
#undef PG8_WAIT_V
#undef PG8_NEXT
#undef PG8_WAIT_L
#undef PG8_BAR
#undef PG8_SCHED
}
}
using pg8::Acc; using pg8::Unit;

#define EPI_FENCE() asm volatile("" ::: "memory")

struct EpiIn {
    static constexpr bool PERM = true;
    bf16_t* O; const float* lbf; const float* lbb; float* vsum; float* vssq; int seg_base;
    template <int SEG> __device__ __forceinline__ void body(const Acc& acc, const Unit& u, int wr, int wc, int fr, int fq) const {
        const int row0 = u.pm * 256 + wr * 64 + fr, col0 = u.pn * 256 + wc * 32 + 8 * fq;
        f32x2 lb[2][4], oml[2][4];
        if (SEG == 1 || SEG == 2) {
            const float* lp = (SEG == 1 ? lbf : lbb) + (col0 - SEG * 1024);
#pragma unroll
            for (int bj = 0; bj < 2; ++bj)
#pragma unroll
                for (int e = 0; e < 4; ++e) { lb[bj][e] = (f32x2){lp[bj * 128 + 2 * e], lp[bj * 128 + 2 * e + 1]}; oml[bj][e] = 1.0f - lb[bj][e]; }
        }
#pragma unroll
        for (int ai = 0; ai < 2; ++ai)
#pragma unroll
            for (int m = 0; m < 4; ++m) {
                const int row = row0 + ai * 128 + m * 16;
                bf16_t* rowp = O + (size_t)(u.pm * 4 + ai * 2 + wr) * PT_CHUNK + (size_t)SEG * PT_SEG + (size_t)((u.pn & 3) * 2) * PT_TILE + (m * 16 + fr) * 128 + wc * 32 + 8 * fq;
                f32x2 s1 = {0.f, 0.f}, s2 = {0.f, 0.f};
#pragma unroll
                for (int bj = 0; bj < 2; ++bj) {
                    f32x2 v[4];
                    v[0] = (f32x2){acc[ai][bj][m][0][0], acc[ai][bj][m][0][1]}; v[1] = (f32x2){acc[ai][bj][m][0][2], acc[ai][bj][m][0][3]};
                    v[2] = (f32x2){acc[ai][bj][m][1][0], acc[ai][bj][m][1][1]}; v[3] = (f32x2){acc[ai][bj][m][1][2], acc[ai][bj][m][1][3]};
                    u32x4 w;
                    if (SEG == 1 || SEG == 2) {
                        unsigned hw[4];
#pragma unroll
                        for (int e = 0; e < 4; ++e) { const f32x2 f = lb[bj][e] + oml[bj][e] * sigmoid_pk(v[e]); hw[e] = cvt_pk_f16v(log2_pk(f) * 0.6931471805599453f); }
                        w.x = hw[0]; w.y = hw[1]; w.z = hw[2]; w.w = hw[3];
                    } else {
#pragma unroll
                        for (int e = 0; e < 4; ++e) {
                            if (SEG == 0 || SEG == 4) v[e] = silu_pk(v[e]);
                            if (SEG == 5 || SEG == 6) v[e] = gelu_pk(v[e]);
                            if (SEG == 6) { s1 += v[e]; s2 += v[e] * v[e]; }
                        }
                        w.x = cvt_pk_bf16v(v[0]); w.y = cvt_pk_bf16v(v[1]); w.z = cvt_pk_bf16v(v[2]); w.w = cvt_pk_bf16v(v[3]);
                    }
                    *(u32x4*)(rowp + bj * PT_TILE) = w;
                    EPI_FENCE();
                }
                if (SEG == 6) {
                    float a1 = s1.x + s1.y, a2 = s2.x + s2.y;
                    a1 += __shfl_xor(a1, 16); a1 += __shfl_xor(a1, 32); a2 += __shfl_xor(a2, 16); a2 += __shfl_xor(a2, 32);
                    if (fq == 0) { atomic_addf(vsum + row, a1); atomic_addf(vssq + row, a2); }
                }
            }
    }
    __device__ __forceinline__ void operator()(const Acc& acc, const Unit& u, int wr, int wc, int fr, int fq) const {
        switch ((u.pn >> 2) + seg_base) {
            case 0: body<0>(acc, u, wr, wc, fr, fq); break;
            case 1: body<1>(acc, u, wr, wc, fr, fq); break;
            case 2: body<2>(acc, u, wr, wc, fr, fq); break;
            case 3: body<3>(acc, u, wr, wc, fr, fq); break;
            case 4: body<4>(acc, u, wr, wc, fr, fq); break;
            case 5: body<5>(acc, u, wr, wc, fr, fq); break;
            default: body<6>(acc, u, wr, wc, fr, fq); break;
        }
    }
};
struct EpiInT {
    static constexpr bool PERM = true;
    bf16_t* O; const float* lbf; const float* lbb;
    template <int SEG> __device__ __forceinline__ void body(const Acc& acc, const Unit& u, int wr, int wc, int fr, int fq) const {
        const int chunk0 = u.pn * 4 + (wc >> 1), s0 = 32 * (wc & 1) + 8 * fq;
        float lbv[2][4];
        if (SEG == 1 || SEG == 2) {
            const float* lp = (SEG == 1 ? lbf : lbb) + (u.pm & 3) * 256 + 64 * wr + fr;
#pragma unroll
            for (int ai = 0; ai < 2; ++ai)
#pragma unroll
                for (int m = 0; m < 4; ++m) lbv[ai][m] = lp[ai * 128 + 16 * m];
        }
#pragma unroll
        for (int ai = 0; ai < 2; ++ai)
#pragma unroll
            for (int m = 0; m < 4; ++m) {
                const int hh = (u.pm & 3) * 2 + ai, kk = 64 * wr + 16 * m + fr;
                bf16_t* tp = O + (size_t)SEG * PT_SEG + (size_t)hh * PT_TILE + kk * 64 + s0;
                const float l = (SEG == 1 || SEG == 2) ? lbv[ai][m] : 0.f, oml = 1.0f - l;
#pragma unroll
                for (int bj = 0; bj < 2; ++bj) {
                    f32x2 v[4];
                    v[0] = (f32x2){acc[ai][bj][m][0][0], acc[ai][bj][m][0][1]}; v[1] = (f32x2){acc[ai][bj][m][0][2], acc[ai][bj][m][0][3]};
                    v[2] = (f32x2){acc[ai][bj][m][1][0], acc[ai][bj][m][1][1]}; v[3] = (f32x2){acc[ai][bj][m][1][2], acc[ai][bj][m][1][3]};
                    u32x4 w;
                    if (SEG == 1 || SEG == 2) {
                        unsigned hw[4];
#pragma unroll
                        for (int e = 0; e < 4; ++e) { const f32x2 f = sigmoid_pk(v[e]) * oml + l; hw[e] = cvt_pk_f16v(log2_pk(f) * 0.6931471805599453f); }
                        w.x = hw[0]; w.y = hw[1]; w.z = hw[2]; w.w = hw[3];
                    } else {
                        if (SEG == 0) {
#pragma unroll
                            for (int e = 0; e < 4; ++e) v[e] = silu_pk(v[e]);
                        }
                        w.x = cvt_pk_bf16v(v[0]); w.y = cvt_pk_bf16v(v[1]); w.z = cvt_pk_bf16v(v[2]); w.w = cvt_pk_bf16v(v[3]);
                    }
                    *(u32x4*)(tp + (size_t)(chunk0 + 2 * bj) * PT_CHUNK) = w;
                    EPI_FENCE();
                }
            }
    }
    __device__ __forceinline__ void operator()(const Acc& acc, const Unit& u, int wr, int wc, int fr, int fq) const {
        switch (u.pm >> 2) {
            case 0: body<0>(acc, u, wr, wc, fr, fq); break;
            case 1: body<1>(acc, u, wr, wc, fr, fq); break;
            case 2: body<2>(acc, u, wr, wc, fr, fq); break;
            default: body<3>(acc, u, wr, wc, fr, fq); break;
        }
    }
};
template <bool BB> struct EpiRes {
    static constexpr bool PERM = true;
    const float* base; bf16_t* hb; float* ssq;
    __device__ __forceinline__ void operator()(const Acc& acc, const Unit& u, int wr, int wc, int fr, int fq) const {
        const int row0 = u.pm * 256 + wr * 64 + fr, col0 = u.pn * 256 + wc * 32 + 8 * fq;
#pragma unroll
        for (int ai = 0; ai < 2; ++ai) {
            f32x4 bv[4][2][2]; u32x4 bw[4][2];
#pragma unroll
            for (int m = 0; m < 4; ++m) { const size_t off = (size_t)(row0 + ai * 128 + m * 16) * DM + col0;
#pragma unroll
                for (int bj = 0; bj < 2; ++bj) {
                    if (BB) bw[m][bj] = *(const u32x4*)(hb + off + bj * 128);
                    else { bv[m][bj][0] = *(const f32x4*)(base + off + bj * 128); bv[m][bj][1] = *(const f32x4*)(base + off + bj * 128 + 4); } } }
            EPI_FENCE();
#pragma unroll
            for (int m = 0; m < 4; ++m) {
                const int row = row0 + ai * 128 + m * 16; const size_t off = (size_t)row * DM + col0;
                float s2 = 0.f;
#pragma unroll
                for (int bj = 0; bj < 2; ++bj) {
                    f32x4 b0, b1;
                    if (BB) { const u32x4 q = bw[m][bj]; b0 = (f32x4){bflo(q.x), bfhi(q.x), bflo(q.y), bfhi(q.y)}; b1 = (f32x4){bflo(q.z), bfhi(q.z), bflo(q.w), bfhi(q.w)}; }
                    else { b0 = bv[m][bj][0]; b1 = bv[m][bj][1]; }
                    const f32x4 h0 = b0 + acc[ai][bj][m][0], h1 = b1 + acc[ai][bj][m][1];
                    u32x4 w; w.x = cvt_pk_bf16(h0[0], h0[1]); w.y = cvt_pk_bf16(h0[2], h0[3]); w.z = cvt_pk_bf16(h1[0], h1[1]); w.w = cvt_pk_bf16(h1[2], h1[3]);
                    *(u32x4*)(hb + off + bj * 128) = w;
                    s2 += (h0[0] * h0[0] + h0[1] * h0[1]) + (h0[2] * h0[2] + h0[3] * h0[3]) + (h1[0] * h1[0] + h1[1] * h1[1]) + (h1[2] * h1[2] + h1[3] * h1[3]);
                }
                s2 += __shfl_xor(s2, 16); s2 += __shfl_xor(s2, 32);
                if (fq == 0) atomic_addf(ssq + row, s2);
            }
            EPI_FENCE();
        }
    }
};
struct EpiGU {
    static constexpr bool PERM = true;
    bf16_t* act; const float* ssq;
    __device__ __forceinline__ void operator()(const Acc& acc, const Unit& u, int wr, int wc, int fr, int fq) const {
        const int row0 = u.pm * 256 + wr * 64 + fr, col0 = u.pn * 128 + wc * 32 + 8 * fq;
        float rsv[2][4];
#pragma unroll
        for (int ai = 0; ai < 2; ++ai)
#pragma unroll
            for (int m = 0; m < 4; ++m) rsv[ai][m] = ssq[row0 + ai * 128 + m * 16];
        EPI_FENCE();
#pragma unroll
        for (int ai = 0; ai < 2; ++ai)
#pragma unroll
            for (int m = 0; m < 4; ++m) {
                const int row = row0 + ai * 128 + m * 16;
                const float rs = __builtin_amdgcn_rsqf(rsv[ai][m] * (1.0f / DM) + EPS);
                const float nrs = rs * (-1.4426950408889634f), rs2 = rs * rs;
                unsigned ow[4];
#pragma unroll
                for (int e = 0; e < 4; ++e) {
                    const f32x2 g2 = {acc[ai][0][m][e >> 1][2 * (e & 1)], acc[ai][0][m][e >> 1][2 * (e & 1) + 1]}, u2 = {acc[ai][1][m][e >> 1][2 * (e & 1)], acc[ai][1][m][e >> 1][2 * (e & 1) + 1]};
                    ow[e] = cvt_pk_bf16v((g2 * u2) * (rcp_pk(exp2_pk(g2 * nrs) + 1.0f) * rs2));
                }
                u32x4 w; w.x = ow[0]; w.y = ow[1]; w.z = ow[2]; w.w = ow[3];
                *(u32x4*)(act + (size_t)row * FF + col0) = w;
                EPI_FENCE();
            }
    }
};
struct EpiPP {
    static constexpr bool PERM = true;
    bf16_t* O;
    __device__ __forceinline__ void operator()(const Acc& acc, const Unit& u, int wr, int wc, int fr, int fq) const {
        const int row0 = u.pm * 256 + wr * 64 + fr, col0 = u.pn * 256 + wc * 32 + 8 * fq;
#pragma unroll
        for (int ai = 0; ai < 2; ++ai)
#pragma unroll
            for (int m = 0; m < 4; ++m) {
                bf16_t* rowp = O + (size_t)(row0 + ai * 128 + m * 16) * DM + col0;
#pragma unroll
                for (int bj = 0; bj < 2; ++bj) {
                    const f32x4 v0 = acc[ai][bj][m][0], v1 = acc[ai][bj][m][1];
                    u32x4 w; w.x = cvt_pk_bf16(v0[0], v0[1]); w.y = cvt_pk_bf16(v0[2], v0[3]); w.z = cvt_pk_bf16(v1[0], v1[1]); w.w = cvt_pk_bf16(v1[2], v1[3]);
                    *(u32x4*)(rowp + bj * 128) = w;
                    EPI_FENCE();
                }
            }
    }
};
struct EpiPle {
    static constexpr bool PERM = true;
    const bf16_t* hb; bf16_t* h3b; const bf16_t* pp; const float* ssq_in; float* ssq_out;
    __device__ __forceinline__ void operator()(const Acc& acc, const Unit& u, int wr, int wc, int fr, int fq) const {
        const int row0 = u.pm * 256 + wr * 64 + fr, col0 = u.pn * 256 + wc * 32 + 8 * fq;
#pragma unroll
        for (int ai = 0; ai < 2; ++ai) {
            u32x4 bw[4][2], pw[4][2]; float rsv[4];
#pragma unroll
            for (int m = 0; m < 4; ++m) { const int row = row0 + ai * 128 + m * 16; const size_t off = (size_t)row * DM + col0;
                rsv[m] = ssq_in[row];
#pragma unroll
                for (int bj = 0; bj < 2; ++bj) { bw[m][bj] = *(const u32x4*)(hb + off + bj * 128); pw[m][bj] = *(const u32x4*)(pp + off + bj * 128); } }
            EPI_FENCE();
#pragma unroll
            for (int m = 0; m < 4; ++m) {
                const int row = row0 + ai * 128 + m * 16; const size_t off = (size_t)row * DM + col0;
                const float rs = __builtin_amdgcn_rsqf(rsv[m] * (1.0f / DM) + EPS);
                float s2 = 0.f;
#pragma unroll
                for (int bj = 0; bj < 2; ++bj) {
                    const u32x4 q = bw[m][bj], pq = pw[m][bj];
                    f32x4 h0, h1;
                    h0[0] = bflo(q.x) + fsigmoid(acc[ai][bj][m][0][0] * rs) * bflo(pq.x); h0[1] = bfhi(q.x) + fsigmoid(acc[ai][bj][m][0][1] * rs) * bfhi(pq.x);
                    h0[2] = bflo(q.y) + fsigmoid(acc[ai][bj][m][0][2] * rs) * bflo(pq.y); h0[3] = bfhi(q.y) + fsigmoid(acc[ai][bj][m][0][3] * rs) * bfhi(pq.y);
                    h1[0] = bflo(q.z) + fsigmoid(acc[ai][bj][m][1][0] * rs) * bflo(pq.z); h1[1] = bfhi(q.z) + fsigmoid(acc[ai][bj][m][1][1] * rs) * bfhi(pq.z);
                    h1[2] = bflo(q.w) + fsigmoid(acc[ai][bj][m][1][2] * rs) * bflo(pq.w); h1[3] = bfhi(q.w) + fsigmoid(acc[ai][bj][m][1][3] * rs) * bfhi(pq.w);
                    u32x4 w; w.x = cvt_pk_bf16(h0[0], h0[1]); w.y = cvt_pk_bf16(h0[2], h0[3]); w.z = cvt_pk_bf16(h1[0], h1[1]); w.w = cvt_pk_bf16(h1[2], h1[3]);
                    *(u32x4*)(h3b + off + bj * 128) = w;
                    s2 += (h0[0] * h0[0] + h0[1] * h0[1]) + (h0[2] * h0[2] + h0[3] * h0[3]) + (h1[0] * h1[0] + h1[1] * h1[1]) + (h1[2] * h1[2] + h1[3] * h1[3]);
                }
                s2 += __shfl_xor(s2, 16); s2 += __shfl_xor(s2, 32);
                if (fq == 0) atomic_addf(ssq_out + row, s2);
            }
            EPI_FENCE();
        }
    }
};

struct Args { const float* in[21]; float* out; unsigned char* ws; int ph_lo, ph_hi; };
struct Frame {
    LAS unsigned char* lds; int G, bid;
    const float* const* in; float* out; unsigned char* ws;
};
__device__ __forceinline__ int fresh_tid() { int t = threadIdx.x; asm volatile("" : "+v"(t)); return t; }
#define PHASE_IDS() const int tid = fresh_tid(), lane = tid & 63, wave = __builtin_amdgcn_readfirstlane(tid >> 6); (void)lane; (void)wave
#define F_IN(i) (F.in[i])
#define F_x F_IN(0)
#define F_p F_IN(1)
#define F_norm_mix_g F_IN(2)
#define F_w_in F_IN(3)
#define F_lbfl F_IN(4)
#define F_lbbl F_IN(5)
#define F_onorm_g F_IN(6)
#define F_ln_g F_IN(7)
#define F_ln_b F_IN(8)
#define F_sgu_w F_IN(9)
#define F_sgu_b F_IN(10)
#define F_sgu_onorm F_IN(11)
#define F_w_out F_IN(12)
#define F_norm_ffn_g F_IN(13)
#define F_w_gate F_IN(14)
#define F_w_up F_IN(15)
#define F_w_down F_IN(16)
#define F_norm_ple_g F_IN(17)
#define F_w_pg F_IN(18)
#define F_w_pp F_IN(19)
#define F_final_g F_IN(20)
#define F_ctl ((float*)(F.ws + WS_CTL))
#define F_WIN ((bf16_t*)(F.ws + WS_WIN))
#define F_WOUT ((bf16_t*)(F.ws + WS_WOUT))
#define F_WGU ((bf16_t*)(F.ws + WS_WGU))
#define F_WDN ((bf16_t*)(F.ws + WS_WDN))
#define F_WPG ((bf16_t*)(F.ws + WS_WPG))
#define F_WPP ((bf16_t*)(F.ws + WS_WPP))
#define F_SGUW ((bf16_t*)(F.ws + WS_SGUW))
#define F_PBF ((bf16_t*)(F.ws + WS_PBF))
#define F_PROJ ((bf16_t*)(F.ws + WS_PROJ))
#define F_CAT ((bf16_t*)(F.ws + WS_CAT))
#define F_HB ((bf16_t*)(F.ws + WS_HB))
#define F_ACT ((bf16_t*)(F.ws + WS_ACT))
#define F_PP ((bf16_t*)(F.ws + WS_PP))
#define F_S ((bf16_t*)(F.ws + WS_S))
#define F_H3B ((bf16_t*)(F.ws + WS_ACT))
#define F_DEC ((float*)(F.ws + WS_DEC))
#define F_SEG ((bf16_t*)(F.ws + WS_SEG))
#define F_CARRY ((bf16_t*)(F.ws + WS_CARRY))
#define F_DSEG ((float*)(F.ws + WS_DSEG))
#define LDS_WAIT() asm volatile("s_waitcnt lgkmcnt(0)" ::: "memory")
#define LBAR() do { asm volatile("s_waitcnt lgkmcnt(0)" ::: "memory"); __builtin_amdgcn_s_barrier(); asm volatile("" ::: "memory"); } while (0)

constexpr int TRP = 136;
__device__ __forceinline__ void p0_transpose_item(const float* W, int K, int N, bf16_t* WT, const float* ksc, int mode, LAS unsigned char* scr, int item, int lane) {
    const int nblk = N / 64, kb = item / nblk, nb = item % nblk, k0 = 64 * kb, n0 = 64 * nb;
    const int lr = lane >> 4, lc = lane & 15;
#pragma unroll 8
    for (int i = 0; i < 16; ++i) { const int kk = 4 * i + lr; f32x4 v = *(const f32x4*)(W + (size_t)(k0 + kk) * N + n0 + 4 * lc); if (ksc) v = v * ksc[k0 + kk];
        u32x2 w; w.x = cvt_pk_bf16(v[0], v[1]); w.y = cvt_pk_bf16(v[2], v[3]); *(LAS u32x2*)(scr + kk * TRP + lc * 8) = w; }
    LDS_WAIT(); asm volatile("" ::: "memory");
    const int d0 = mode == 0 ? n0 : (256 * (n0 >> 7) + (n0 & 127) + (mode == 2 ? 128 : 0));
    const int c = lane & 7;
#pragma unroll
    for (int j = 0; j < 8; ++j) { const int n = (lane >> 3) + 8 * j; const LAS unsigned char* sp = scr + (8 * c) * TRP + n * 2;
        unsigned short e[8];
#pragma unroll
        for (int q = 0; q < 8; ++q) e[q] = *(const LAS unsigned short*)(sp + q * TRP);
        u32x4 o; o.x = e[0] | ((unsigned)e[1] << 16); o.y = e[2] | ((unsigned)e[3] << 16); o.z = e[4] | ((unsigned)e[5] << 16); o.w = e[6] | ((unsigned)e[7] << 16);
        *(u32x4*)(WT + (size_t)(d0 + n) * K + k0 + 8 * c) = o; }
    LDS_WAIT(); asm volatile("" ::: "memory");
}
__device__ __forceinline__ void p0_prologue(Frame& F) {
    PHASE_IDS();
    LAS unsigned char* scr = F.lds + wave * 16384;
    const int gw = F.bid * 8 + wave, NGW = F.G * 8;
    const int gt = F.bid * 512 + tid, NGT = F.G * 512;
    constexpr int I_IN = (DM / 64) * (INC / 64), I_OUT = (DM / 64) * (DM / 64), I_G = (DM / 64) * (FF / 64), I_DN = (FF / 64) * (DM / 64), I_PP = (PLE / 64) * (DM / 64);
    constexpr int NITEMS = I_IN + I_OUT + 2 * I_G + I_DN + I_OUT + I_PP;
    for (int it = gw; it < NITEMS; it += NGW) {
        int r = it;
        if (r < I_IN) { p0_transpose_item(F_w_in, DM, INC, F_WIN, nullptr, 0, scr, r, lane); continue; } r -= I_IN;
        if (r < I_OUT) { p0_transpose_item(F_w_out, DM, DM, F_WOUT, nullptr, 0, scr, r, lane); continue; } r -= I_OUT;
        if (r < I_G) { p0_transpose_item(F_w_gate, DM, FF, F_WGU, F_norm_ffn_g, 1, scr, r, lane); continue; } r -= I_G;
        if (r < I_G) { p0_transpose_item(F_w_up, DM, FF, F_WGU, F_norm_ffn_g, 2, scr, r, lane); continue; } r -= I_G;
        if (r < I_DN) { p0_transpose_item(F_w_down, FF, DM, F_WDN, nullptr, 0, scr, r, lane); continue; } r -= I_DN;
        if (r < I_OUT) { p0_transpose_item(F_w_pg, DM, DM, F_WPG, F_norm_ple_g, 0, scr, r, lane); continue; } r -= I_OUT;
        p0_transpose_item(F_w_pp, PLE, DM, F_WPP, nullptr, 0, scr, r, lane);
    }
    {
        f32x4 gv[8];
#pragma unroll
        for (int j = 0; j < 8; ++j) gv[j] = *((const f32x4*)F_norm_mix_g + lane + 64 * j);
        for (int m = gw; m < M; m += 2 * NGW) {
            const int m2 = (m + NGW < M) ? m + NGW : m;
            const f32x4* xr = (const f32x4*)(F_x + (size_t)m * DM) + lane; const f32x4* xr2 = (const f32x4*)(F_x + (size_t)m2 * DM) + lane;
            f32x4 v[8], v2[8]; float sa = 0.f, sb = 0.f;
#pragma unroll
            for (int j = 0; j < 8; ++j) { v[j] = xr[64 * j]; v2[j] = xr2[64 * j]; }
#pragma unroll
            for (int j = 0; j < 8; ++j) { sa += (v[j][0] * v[j][0] + v[j][1] * v[j][1]) + (v[j][2] * v[j][2] + v[j][3] * v[j][3]); sb += (v2[j][0] * v2[j][0] + v2[j][1] * v2[j][1]) + (v2[j][2] * v2[j][2] + v2[j][3] * v2[j][3]); }
            const float rs = __builtin_amdgcn_rsqf(wave_sum(sa) * (1.0f / DM) + EPS), rs2 = __builtin_amdgcn_rsqf(wave_sum(sb) * (1.0f / DM) + EPS);
            u32x2* o = (u32x2*)(F_HB + (size_t)m * DM) + lane; u32x2* o2 = (u32x2*)(F_HB + (size_t)m2 * DM) + lane;
#pragma unroll
            for (int j = 0; j < 8; ++j) { u32x2 w; w.x = cvt_pk_bf16(v[j][0] * rs * gv[j][0], v[j][1] * rs * gv[j][1]); w.y = cvt_pk_bf16(v[j][2] * rs * gv[j][2], v[j][3] * rs * gv[j][3]); o[64 * j] = w;
                u32x2 w2; w2.x = cvt_pk_bf16(v2[j][0] * rs2 * gv[j][0], v2[j][1] * rs2 * gv[j][1]); w2.y = cvt_pk_bf16(v2[j][2] * rs2 * gv[j][2], v2[j][3] * rs2 * gv[j][3]); o2[64 * j] = w2; }
        }
    }
    for (int i = gt; i < M * PLE / 4; i += NGT) { const f32x4 v = ((const f32x4*)F_p)[i]; u32x2 w; w.x = cvt_pk_bf16(v[0], v[1]); w.y = cvt_pk_bf16(v[2], v[3]); ((u32x2*)F_PBF)[i] = w; }
    for (int i = gt; i < 8 * 128 * 128 / 4; i += NGT) { const f32x4 v = ((const f32x4*)F_sgu_w)[i]; u32x2 w; w.x = cvt_pk_bf16(v[0], v[1]); w.y = cvt_pk_bf16(v[2], v[3]); ((u32x2*)F_SGUW)[i] = w; }
    for (int i = gt; i < 2048; i += NGT) { const float* l = (i < 1024) ? F_lbfl : F_lbbl; const int c = i & 1023; const float a = l[c], b = l[1024 + c], mx = fmaxf(a, b), ea = __expf(a - mx), eb = __expf(b - mx);
        F_ctl[(i < 1024 ? CT_LBF : CT_LBB) + c] = ea / (ea + eb); }
    for (int i = gt; i < 5 * M; i += NGT) F_ctl[CT_VSUM + i] = 0.f;
}

__device__ __forceinline__ bf16x8 ldfrag(const LAS unsigned char* base, int pitch, int row, int kbyte) { return *(const LAS bf16x8*)(base + row * pitch + kbyte); }
#define MFMA16(a, b, c) __builtin_amdgcn_mfma_f32_16x16x32_bf16((b), (a), (c), 0, 0, 0)

constexpr int P128 = 272, P64 = 144;
constexpr int H_QT = 0, H_KT = H_QT + 64 * P128, H_QTB = H_KT + 64 * P128, H_KTB = H_QTB + 64 * P128, H_SS = H_KTB + 64 * P128, H_VT = H_SS + 128 * P128, H_PB = H_VT + 128 * P64, H_TOT = H_PB + 64 * P64, H_RSX = H_TOT + 4096, H_KTH = H_RSX + 512, H_DLF = H_KTH + 128 * P64, H_END = H_DLF + 512;
constexpr int H_RAWF = 0, H_RAWB = 16384, H_RAWQ = 32768, H_RAWV = 49152;
static_assert(H_RAWV + 16384 <= H_SS && H_END <= LDS_BARST, "raw alias / lds");
static_assert(H_END <= LDS_BYTES, "lds");

__device__ __forceinline__ u32x4 pack8(const float* v) { u32x4 w; w.x = cvt_pk_bf16(v[0], v[1]); w.y = cvt_pk_bf16(v[2], v[3]); w.z = cvt_pk_bf16(v[4], v[5]); w.w = cvt_pk_bf16(v[6], v[7]); return w; }
__device__ __forceinline__ int invperm32(int kk) { return 16 * ((kk >> 2) & 1) + (((kk >> 3) << 2) | (kk & 3)); }
__device__ __forceinline__ unsigned short lds_u16(const LAS unsigned char* p) { return *(const LAS unsigned short*)p; }

constexpr int NSEGC = 16, NSEG = BATCH * NHEAD * (NCHUNK / NSEGC);
constexpr int T_KT = 0, T_DL = 4 * 128 * P64, T_END = T_DL + 2048;
static_assert(T_END <= LDS_BYTES, "s1 lds");
__device__ __forceinline__ void unpack_lf16(const u32x4 (&r)[2], float (&o)[16]) {
#pragma unroll
    for (int q = 0; q < 2; ++q)
#pragma unroll
        for (int e = 0; e < 4; ++e) { o[8 * q + 2 * e] = h2f((unsigned short)(r[q][e] & 0xffffu)) * 1.4426950408889634f; o[8 * q + 2 * e + 1] = h2f((unsigned short)(r[q][e] >> 16)) * 1.4426950408889634f; }
}
__device__ __forceinline__ void hgrn_s1(Frame& F) {
    LAS unsigned char* lds = F.lds;
    PHASE_IDS();
    const int k = tid >> 2, tq = tid & 3, w = wave, fr = lane & 15, fq = lane >> 4;
    const int kr = (k & ~31) + invperm32(k & 31);
    const int lq = lane & ~3;
    u32x4 rlf[2], rlb[2], raf[2], rab[2];
#define S1_LOAD(bh_, cf_, cb_) do { const bf16_t* tf_ = F_PROJ + (size_t)(((bh_) >> 3) * 256 + (cf_)) * PT_CHUNK + ((bh_) & 7) * PT_TILE; const bf16_t* tb_ = F_PROJ + (size_t)(((bh_) >> 3) * 256 + (cb_)) * PT_CHUNK + ((bh_) & 7) * PT_TILE; \
        rlf[0] = *(const u32x4*)(tf_ + 1 * PT_SEG + k * 64 + 16 * tq); rlf[1] = *(const u32x4*)(tf_ + 1 * PT_SEG + k * 64 + 16 * tq + 8); \
        rlb[0] = *(const u32x4*)(tb_ + 2 * PT_SEG + k * 64 + 16 * tq); rlb[1] = *(const u32x4*)(tb_ + 2 * PT_SEG + k * 64 + 16 * tq + 8); \
        raf[0] = *(const u32x4*)(tf_ + 3 * PT_SEG + (16 * w + fr) * 64 + 8 * fq); raf[1] = *(const u32x4*)(tf_ + 3 * PT_SEG + (16 * w + fr) * 64 + 32 + 8 * fq); \
        rab[0] = *(const u32x4*)(tb_ + 3 * PT_SEG + (16 * w + fr) * 64 + 8 * fq); rab[1] = *(const u32x4*)(tb_ + 3 * PT_SEG + (16 * w + fr) * 64 + 32 + 8 * fq); } while (0)
    for (int sg = F.bid; sg < NSEG; sg += F.G) {
        const int bh = sg >> 4, seg = sg & 15;
        f32x4 Rf[4][2], Rb[4][2];
#pragma unroll
        for (int gg = 0; gg < 4; ++gg)
#pragma unroll
            for (int n = 0; n < 2; ++n) { Rf[gg][n] = (f32x4){0.f, 0.f, 0.f, 0.f}; Rb[gg][n] = (f32x4){0.f, 0.f, 0.f, 0.f}; }
        float cumf = 0.f, cumb = 0.f;
        S1_LOAD(bh, NSEGC * seg, NSEGC * seg + NSEGC - 1);
#pragma unroll 1
        for (int i = 0; i < NSEGC; ++i) {
            const int cf = NSEGC * seg + i, cb = NSEGC * seg + NSEGC - 1 - i, par = i & 1;
            float lff[16], lfb[16];
            unpack_lf16(rlf, lff); unpack_lf16(rlb, lfb);
            const bf16x8 a0f = __builtin_bit_cast(bf16x8, raf[0]), a1f = __builtin_bit_cast(bf16x8, raf[1]), a0b = __builtin_bit_cast(bf16x8, rab[0]), a1b = __builtin_bit_cast(bf16x8, rab[1]);
#pragma unroll
            for (int dir = 1; dir < 2; ++dir) {
                bf16_t* Sd = F_S + (size_t)((bh * 2 + dir) * 256 + (dir ? cb : cf)) * 16384 + (size_t)(16 * w + fr) * 128 + 8 * fq;
#pragma unroll
                for (int gg = 0; gg < 4; ++gg) { const f32x4 r0 = dir ? Rb[gg][0] : Rf[gg][0], r1 = dir ? Rb[gg][1] : Rf[gg][1];
                    u32x4 o; o.x = cvt_pk_bf16(r0[0], r0[1]); o.y = cvt_pk_bf16(r0[2], r0[3]); o.z = cvt_pk_bf16(r1[0], r1[1]); o.w = cvt_pk_bf16(r1[2], r1[3]);
                    *(u32x4*)(Sd + 32 * gg) = o; }
            }
            if (i + 1 < NSEGC) S1_LOAD(bh, cf + 1, cb - 1);
            float tf = 0.f, tb = 0.f;
#pragma unroll
            for (int j = 0; j < 16; ++j) { tf += lff[j]; tb += lfb[j]; }
            float offF = 0.f, offB = 0.f, totf = 0.f, totb = 0.f;
#pragma unroll
            for (int q = 0; q < 4; ++q) { const float a = __shfl(tf, lq + q), bb = __shfl(tb, lq + q); totf += a; totb += bb; if (q > tq) offF += a; if (q < tq) offB += bb; }
            float kh[16];
            {
                float run = offF, ep = __builtin_amdgcn_exp2f(run);
#pragma unroll
                for (int j = 15; j >= 0; --j) { run += lff[j]; const float en = __builtin_amdgcn_exp2f(run); kh[j] = ep - en; ep = en; }
                LAS unsigned char* dst = lds + T_KT + (par * 2 + 0) * 128 * P64 + kr * P64 + tq * 32;
                *(LAS u32x4*)dst = pack8(kh); *(LAS u32x4*)(dst + 16) = pack8(kh + 8);
            }
            {
                float run = offB, ep = __builtin_amdgcn_exp2f(run);
#pragma unroll
                for (int j = 0; j < 16; ++j) { run += lfb[j]; const float en = __builtin_amdgcn_exp2f(run); kh[j] = ep - en; ep = en; }
                LAS unsigned char* dst = lds + T_KT + (par * 2 + 1) * 128 * P64 + kr * P64 + tq * 32;
                *(LAS u32x4*)dst = pack8(kh); *(LAS u32x4*)(dst + 16) = pack8(kh + 8);
            }
            LAS float* DL = (LAS float*)(lds + T_DL) + par * 256;
            if (tq == 0) { DL[k] = __builtin_amdgcn_exp2f(totf); }
            if (tq == 1) { F_DEC[(size_t)((bh * 2 + 1) * 256 + cb) * 128 + k] = __builtin_amdgcn_exp2f(cumb); DL[128 + k] = __builtin_amdgcn_exp2f(totb); }
            cumf += totf; cumb += totb;
            LBAR();
#pragma unroll
            for (int dir = 0; dir < 2; ++dir) {
                const LAS unsigned char* kt = lds + T_KT + (par * 2 + dir) * 128 * P64;
                const bf16x8 a0 = dir ? a0b : a0f, a1 = dir ? a1b : a1f;
#pragma unroll
                for (int gg = 0; gg < 4; ++gg) {
                    f32x4 r0 = dir ? Rb[gg][0] : Rf[gg][0], r1 = dir ? Rb[gg][1] : Rf[gg][1];
                    const f32x4 d0 = *(const LAS f32x4*)(DL + dir * 128 + 32 * gg + 8 * fq), d1 = *(const LAS f32x4*)(DL + dir * 128 + 32 * gg + 8 * fq + 4);
                    r0 = r0 * d0; r1 = r1 * d1;
                    r0 = MFMA16(a0, ldfrag(kt, P64, 32 * gg + fr, fq * 16), r0);
                    r1 = MFMA16(a0, ldfrag(kt, P64, 32 * gg + 16 + fr, fq * 16), r1);
                    r0 = MFMA16(a1, ldfrag(kt, P64, 32 * gg + fr, 64 + fq * 16), r0);
                    r1 = MFMA16(a1, ldfrag(kt, P64, 32 * gg + 16 + fr, 64 + fq * 16), r1);
                    if (dir) { Rb[gg][0] = r0; Rb[gg][1] = r1; } else { Rf[gg][0] = r0; Rf[gg][1] = r1; }
                }
            }
        }
#pragma unroll
        for (int dir = 0; dir < 2; ++dir) {
            bf16_t* Sd = F_SEG + (size_t)((bh * 2 + dir) * 16 + seg) * 16384 + (size_t)(16 * w + fr) * 128 + 8 * fq;
#pragma unroll
            for (int gg = 0; gg < 4; ++gg) { const f32x4 r0 = dir ? Rb[gg][0] : Rf[gg][0], r1 = dir ? Rb[gg][1] : Rf[gg][1];
                u32x4 o; o.x = cvt_pk_bf16(r0[0], r0[1]); o.y = cvt_pk_bf16(r0[2], r0[3]); o.z = cvt_pk_bf16(r1[0], r1[1]); o.w = cvt_pk_bf16(r1[2], r1[3]);
                *(u32x4*)(Sd + 32 * gg) = o; }
        }
        if (tq == 0) F_DSEG[(size_t)((bh * 2 + 0) * 16 + seg) * 128 + k] = __builtin_amdgcn_exp2f(cumf);
        if (tq == 1) F_DSEG[(size_t)((bh * 2 + 1) * 16 + seg) * 128 + k] = __builtin_amdgcn_exp2f(cumb);
        LBAR();
    }
#undef S1_LOAD
}

__device__ __forceinline__ void hgrn_s2(Frame& F) {
    PHASE_IDS();
    for (int e = F.bid * 512 + tid; e < 32 * 4096; e += F.G * 512) {
        const int stream = e >> 12, off = (e & 4095) * 4, dir = stream & 1;
        const bf16_t* Sg = F_SEG + (size_t)stream * 16 * 16384 + off; bf16_t* Cg = F_CARRY + (size_t)stream * 16 * 16384 + off; const float* Dg = F_DSEG + (size_t)stream * 16 * 128 + (off & 127);
        u32x2 loc[16]; f32x4 dd[16];
#pragma unroll
        for (int u = 0; u < 16; ++u) { const int sx = dir ? 15 - u : u; loc[u] = *(const u32x2*)(Sg + (size_t)sx * 16384); dd[u] = *(const f32x4*)(Dg + (size_t)sx * 128); }
        f32x4 run = {0.f, 0.f, 0.f, 0.f};
#pragma unroll
        for (int u = 0; u < 16; ++u) { const int sx = dir ? 15 - u : u;
            u32x2 o; o.x = cvt_pk_bf16(run[0], run[1]); o.y = cvt_pk_bf16(run[2], run[3]); *(u32x2*)(Cg + (size_t)sx * 16384) = o;
            run[0] = dd[u][0] * run[0] + bflo(loc[u].x); run[1] = dd[u][1] * run[1] + bfhi(loc[u].x); run[2] = dd[u][2] * run[2] + bflo(loc[u].y); run[3] = dd[u][3] * run[3] + bfhi(loc[u].y); }
    }
}

__device__ __forceinline__ u32x4 comb8(u32x4 sp, u32x4 cr, f32x4 d0, f32x4 d1) {
    u32x4 o;
    o.x = cvt_pk_bf16(bflo(sp.x) + d0[0] * bflo(cr.x), bfhi(sp.x) + d0[1] * bfhi(cr.x)); o.y = cvt_pk_bf16(bflo(sp.y) + d0[2] * bflo(cr.y), bfhi(sp.y) + d0[3] * bfhi(cr.y));
    o.z = cvt_pk_bf16(bflo(sp.z) + d1[0] * bflo(cr.z), bfhi(sp.z) + d1[1] * bfhi(cr.z)); o.w = cvt_pk_bf16(bflo(sp.w) + d1[2] * bflo(cr.w), bfhi(sp.w) + d1[3] * bfhi(cr.w));
    return o;
}
__device__ __forceinline__ void hgrn_s3(Frame& F) {
    LAS unsigned char* lds = F.lds;
    PHASE_IDS();
    const int k = tid >> 2, tq = tid & 3, w = wave, fr = lane & 15, fq = lane >> 4;
    const int tb = w & 3, half = w >> 2, lq = lane & ~3;
    LAS float* RSX = (LAS float*)(lds + H_RSX);
    const int NL = F.bid < NSEG ? ((NSEG - F.bid + F.G - 1) / F.G) * NSEGC : 0;
    u32x4 rq[2], rlf[2], rlb[2], rv[2], rsb[4], rcb[4]; f32x4 dcb[2];
    f32x4 Rf[4][2];
    const int kr = (k & ~31) + invperm32(k & 31), rrw = ((16 * w + fr) & ~31) + invperm32((16 * w + fr) & 31);
#define S3_DEC(L_, c_, bh_) const int sg_ = F.bid + ((L_) >> 4) * F.G; const int bh_ = sg_ >> 4, c_ = NSEGC * (sg_ & 15) + ((L_) & 15)
    const int pc8 = tid & 15;
#define S3_LOAD(it) do { S3_DEC(it, c_, bh_); const bf16_t* bp_ = F_PROJ + (size_t)((bh_ >> 3) * 256 + c_) * PT_CHUNK + (bh_ & 7) * PT_TILE; \
        _Pragma("unroll") for (int i_ = 0; i_ < 2; ++i_) { rq[i_] = *(const u32x4*)(bp_ + 0 * PT_SEG + k * 64 + 16 * tq + 8 * i_); rlf[i_] = *(const u32x4*)(bp_ + 1 * PT_SEG + k * 64 + 16 * tq + 8 * i_); rlb[i_] = *(const u32x4*)(bp_ + 2 * PT_SEG + k * 64 + 16 * tq + 8 * i_); \
            rv[i_] = *(const u32x4*)(bp_ + 3 * PT_SEG + (tid + 512 * i_) * 8); } } while (0)
#define S3_LOADS(it) do { S3_DEC(it, c_, bh_); const bf16_t* sb_ = F_S + (size_t)((bh_ * 2 + 1) * 256 + c_) * 16384 + tid * 8; \
        _Pragma("unroll") for (int i_ = 0; i_ < 4; ++i_) { rsb[i_] = *(const u32x4*)(sb_ + i_ * 4096); } \
        const float* db_ = F_DEC + (size_t)((bh_ * 2 + 1) * 256 + c_) * 128 + pc8 * 8; \
        dcb[0] = *(const f32x4*)db_; dcb[1] = *(const f32x4*)(db_ + 4); \
        if ((((it) & 15) == 0)) { const bf16_t* cb_ = F_CARRY + (size_t)((bh_ * 2 + 1) * 16 + (c_ >> 4)) * 16384 + tid * 8; \
            _Pragma("unroll") for (int i_ = 0; i_ < 4; ++i_) { rcb[i_] = *(const u32x4*)(cb_ + i_ * 4096); } } } while (0)
    if (NL > 0) { S3_LOAD(0); S3_LOADS(0); }
    f32x4 ogv[2][2];
#pragma unroll
    for (int i = 0; i < 2; ++i) { ogv[i][0] = *(const f32x4*)(F_onorm_g + 64 * half + 32 * i + 8 * fq); ogv[i][1] = *(const f32x4*)(F_onorm_g + 64 * half + 32 * i + 8 * fq + 4); }
    u32x4 po[2]; bf16_t* pop = nullptr;
#pragma unroll 1
    for (int L = 0; L < NL; ++L) {
        S3_DEC(L, c, bh); const int h = bh & 7, b = bh >> 3;
        const size_t row0 = (size_t)b * SEQ + 64 * c;
        const bool has_next = L + 1 < NL;
        if (L > 0) { *(u32x4*)pop = po[0]; *(u32x4*)(pop + 32) = po[1]; }
        if ((L & 15) == 0) {
            const bf16_t* cp = F_CARRY + (size_t)((bh * 2 + 0) * 16 + (c >> 4)) * 16384 + (size_t)(16 * w + fr) * 128 + 8 * fq;
#pragma unroll
            for (int gg = 0; gg < 4; ++gg) { const u32x4 cw = *(const u32x4*)(cp + 32 * gg); Rf[gg][0] = (f32x4){bflo(cw.x), bfhi(cw.x), bflo(cw.y), bfhi(cw.y)}; Rf[gg][1] = (f32x4){bflo(cw.z), bfhi(cw.z), bflo(cw.w), bfhi(cw.w)}; }
        }
        float lff[16], lfb[16], qv[16];
        unpack_lf16(rlf, lff); unpack_lf16(rlb, lfb);
#pragma unroll
        for (int q = 0; q < 2; ++q)
#pragma unroll
            for (int e = 0; e < 4; ++e) { qv[8 * q + 2 * e] = bflo(rq[q][e]); qv[8 * q + 2 * e + 1] = bfhi(rq[q][e]); }
#pragma unroll
        for (int i = 0; i < 2; ++i) { const int p = tid + 512 * i, d = p >> 3, c8 = p & 7, dr_ = (d & ~31) + invperm32(d & 31); *(LAS u32x4*)(lds + H_VT + dr_ * P64 + c8 * 16) = rv[i]; }
        if (has_next) S3_LOAD(L + 1);
        float offF = 0.f, offB = 0.f, offFs = 0.f, totf = 0.f;
        {
            float tf = 0.f, tbw = 0.f;
#pragma unroll
            for (int j = 0; j < 16; ++j) { tf += lff[j]; tbw += lfb[j]; }
#pragma unroll
            for (int q = 0; q < 4; ++q) { const float a_ = __shfl(tf, lq + q), b_ = __shfl(tbw, lq + q); totf += a_; if (q < tq) offF += a_; if (q > tq) { offB += b_; offFs += a_; } }
        }
        {
            float kh[16]; float run = offFs, ep = __builtin_amdgcn_exp2f(run);
#pragma unroll
            for (int j = 15; j >= 0; --j) { run += lff[j]; const float en = __builtin_amdgcn_exp2f(run); kh[j] = ep - en; ep = en; }
            LAS unsigned char* dst = lds + H_KTH + kr * P64 + tq * 32;
            *(LAS u32x4*)dst = pack8(kh); *(LAS u32x4*)(dst + 16) = pack8(kh + 8);
            if (tq == 0) ((LAS float*)(lds + H_DLF))[k] = __builtin_amdgcn_exp2f(totf);
#pragma unroll
            for (int gg = 0; gg < 4; ++gg) { const f32x4 r0 = Rf[gg][0], r1 = Rf[gg][1];
                u32x4 o; o.x = cvt_pk_bf16(r0[0], r0[1]); o.y = cvt_pk_bf16(r0[2], r0[3]); o.z = cvt_pk_bf16(r1[0], r1[1]); o.w = cvt_pk_bf16(r1[2], r1[3]);
                *(LAS u32x4*)(lds + H_SS + rrw * P128 + (32 * gg + 8 * fq) * 2) = o; }
        }
        {
            float run = offF, rp = __builtin_amdgcn_exp2f(-run);
            float runb = offB, rpb = __builtin_amdgcn_exp2f(-runb);
#pragma unroll
            for (int j = 0; j < 16; ++j) { run += lff[j]; const int t = 16 * tq + j; const float rn = __builtin_amdgcn_exp2f(-run);
                *(LAS bf16_t*)(lds + H_QT + t * P128 + k * 2) = (bf16_t)(cvt_pk_bf16(qv[j] * __builtin_amdgcn_exp2f(run), 0.f) & 0xffff);
                *(LAS bf16_t*)(lds + H_KT + t * P128 + k * 2) = (bf16_t)(cvt_pk_bf16(rn - rp, 0.f) & 0xffff); rp = rn;
                const int jb = 15 - j, tb_ = 16 * tq + jb; runb += lfb[jb]; const float rnb = __builtin_amdgcn_exp2f(-runb);
                *(LAS bf16_t*)(lds + H_QTB + tb_ * P128 + k * 2) = (bf16_t)(cvt_pk_bf16(qv[jb] * __builtin_amdgcn_exp2f(runb), 0.f) & 0xffff);
                *(LAS bf16_t*)(lds + H_KTB + tb_ * P128 + k * 2) = (bf16_t)(cvt_pk_bf16(rnb - rpb, 0.f) & 0xffff); rpb = rnb; }
        }
        LBAR();
        f32x4 oacc[4];
#pragma unroll
        for (int i = 0; i < 4; ++i) oacc[i] = (f32x4){0.f, 0.f, 0.f, 0.f};
        {
            f32x4 pf[2], pb[2];
#pragma unroll
            for (int i = 0; i < 2; ++i) { pf[i] = (f32x4){0.f, 0.f, 0.f, 0.f}; pb[i] = (f32x4){0.f, 0.f, 0.f, 0.f}; }
#pragma unroll
            for (int ks = 0; ks < 4; ++ks) {
                const bf16x8 a = ldfrag(lds + H_QT, P128, 16 * tb + fr, ks * 64 + fq * 16), ab = ldfrag(lds + H_QTB, P128, 16 * tb + fr, ks * 64 + fq * 16);
#pragma unroll
                for (int i = 0; i < 2; ++i) { pf[i] = MFMA16(a, ldfrag(lds + H_KT, P128, 16 * (2 * half + i) + fr, ks * 64 + fq * 16), pf[i]); pb[i] = MFMA16(ab, ldfrag(lds + H_KTB, P128, 16 * (2 * half + i) + fr, ks * 64 + fq * 16), pb[i]); }
#pragma unroll
                for (int i = 0; i < 4; ++i) oacc[i] = MFMA16(a, ldfrag(lds + H_SS, P128, 16 * (4 * half + i) + fr, ks * 64 + fq * 16), oacc[i]);
            }
            const int t = 16 * tb + fr;
#pragma unroll
            for (int i = 0; i < 2; ++i) { const int s0 = 16 * (2 * half + i) + 4 * fq; float pv[4];
#pragma unroll
                for (int j = 0; j < 4; ++j) { const int s_ = s0 + j; pv[j] = (s_ <= t ? pf[i][j] : 0.f) + (s_ >= t ? pb[i][j] : 0.f); }
                u32x2 o; o.x = cvt_pk_bf16(pv[0], pv[1]); o.y = cvt_pk_bf16(pv[2], pv[3]);
                *(LAS u32x2*)(lds + H_PB + t * P64 + s0 * 2) = o; }
        }
        {
            const bf16x8 a0 = ldfrag(lds + H_VT, P64, rrw, fq * 16), a1 = ldfrag(lds + H_VT, P64, rrw, 64 + fq * 16);
            const LAS float* DLF = (const LAS float*)(lds + H_DLF);
#pragma unroll
            for (int gg = 0; gg < 4; ++gg) {
                f32x4 r0 = Rf[gg][0], r1 = Rf[gg][1];
                const f32x4 d0 = *(const LAS f32x4*)(DLF + 32 * gg + 8 * fq), d1 = *(const LAS f32x4*)(DLF + 32 * gg + 8 * fq + 4);
                r0 = r0 * d0; r1 = r1 * d1;
                r0 = MFMA16(a0, ldfrag(lds + H_KTH, P64, 32 * gg + fr, fq * 16), r0);
                r1 = MFMA16(a0, ldfrag(lds + H_KTH, P64, 32 * gg + 16 + fr, fq * 16), r1);
                r0 = MFMA16(a1, ldfrag(lds + H_KTH, P64, 32 * gg + fr, 64 + fq * 16), r0);
                r1 = MFMA16(a1, ldfrag(lds + H_KTH, P64, 32 * gg + 16 + fr, 64 + fq * 16), r1);
                Rf[gg][0] = r0; Rf[gg][1] = r1;
            }
        }
        LBAR();
        u32x4 gw[2];
        {
#pragma unroll
            for (int i = 0; i < 4; ++i) { const int p = tid + 512 * i, r = p >> 4, cc = p & 15, rr = (r & ~31) + invperm32(r & 31); *(LAS u32x4*)(lds + H_SS + rr * P128 + cc * 16) = comb8(rsb[i], rcb[i], dcb[0], dcb[1]); }
            if (has_next) S3_LOADS(L + 1);
            const bf16_t* gp = F_PROJ + (size_t)(b * 256 + c) * PT_CHUNK + 4 * PT_SEG + h * PT_TILE + (16 * tb + fr) * 128 + 64 * half + 8 * fq;
#pragma unroll
            for (int i = 0; i < 2; ++i) gw[i] = *(const u32x4*)(gp + 32 * i);
        }
        LBAR();
#pragma unroll
        for (int ks = 0; ks < 4; ++ks) {
            const bf16x8 ab = ldfrag(lds + H_QTB, P128, 16 * tb + fr, ks * 64 + fq * 16);
#pragma unroll
            for (int i = 0; i < 4; ++i) oacc[i] = MFMA16(ab, ldfrag(lds + H_SS, P128, 16 * (4 * half + i) + fr, ks * 64 + fq * 16), oacc[i]);
        }
#pragma unroll
        for (int ks = 0; ks < 2; ++ks) {
            const bf16x8 a = ldfrag(lds + H_PB, P64, 16 * tb + fr, ks * 64 + fq * 16);
#pragma unroll
            for (int i = 0; i < 4; ++i) oacc[i] = MFMA16(a, ldfrag(lds + H_VT, P64, 16 * (4 * half + i) + fr, ks * 64 + fq * 16), oacc[i]);
        }
        {
            const int t = 16 * tb + fr;
            float ss = 0.f;
#pragma unroll
            for (int i = 0; i < 4; ++i) ss += (oacc[i][0] * oacc[i][0] + oacc[i][1] * oacc[i][1]) + (oacc[i][2] * oacc[i][2] + oacc[i][3] * oacc[i][3]);
            ss += __shfl_xor(ss, 16); ss += __shfl_xor(ss, 32);
            if (fq == 0) RSX[half * 64 + t] = ss;
            LBAR();
            const float rs = __builtin_amdgcn_rsqf((RSX[t] + RSX[64 + t]) * (1.0f / 128.0f) + EPS);
            bf16_t* op = F_CAT + (row0 + t) * DM + h * 128;
#pragma unroll
            for (int i = 0; i < 2; ++i) { const int d = 64 * half + 32 * i + 8 * fq;
                const f32x4 og0 = ogv[i][0], og1 = ogv[i][1]; (void)d;
                const f32x4 e0 = oacc[2 * i], e1 = oacc[2 * i + 1];
                u32x4 o; o.x = cvt_pk_bf16(e0[0] * rs * og0[0] * bflo(gw[i].x), e0[1] * rs * og0[1] * bfhi(gw[i].x));
                o.y = cvt_pk_bf16(e0[2] * rs * og0[2] * bflo(gw[i].y), e0[3] * rs * og0[3] * bfhi(gw[i].y));
                o.z = cvt_pk_bf16(e1[0] * rs * og1[0] * bflo(gw[i].z), e1[1] * rs * og1[1] * bfhi(gw[i].z));
                o.w = cvt_pk_bf16(e1[2] * rs * og1[2] * bflo(gw[i].w), e1[3] * rs * og1[3] * bfhi(gw[i].w));
                po[i] = o; }
            pop = op + 64 * half + 8 * fq;
        }
    }
    if (NL > 0) { *(u32x4*)pop = po[0]; *(u32x4*)(pop + 32) = po[1]; }
#undef S3_LOAD
#undef S3_LOADS
#undef S3_DEC
}

constexpr int G_RAW = 0, G_WL = 32768, G_VT = G_WL + 2 * 128 * P128, G_STAT = G_VT + 128 * P128;
static_assert(G_STAT + 1024 <= LDS_BYTES, "sgu lds");
__device__ __forceinline__ void sgu_phase(Frame& F) {
    LAS unsigned char* lds = F.lds;
    PHASE_IDS();
    const int d_e = tid & 127, sq = tid >> 7, w = wave, fr = lane & 15, fq = lane >> 4;
    LAS f32x2* STAT = (LAS f32x2*)(lds + G_STAT);
    const int dr = (d_e & ~31) + invperm32(d_e & 31);
    const float* vsum = F_ctl + CT_VSUM; const float* vssq = F_ctl + CT_VSSQ;
    u32x4 rvp[4], rw[4], uwn[4]; float lgn, lbn, bsn;
#define SGU_LOAD(r0_, g_) do { const bf16_t* vp_ = F_PROJ + (size_t)((r0_) >> 6) * PT_CHUNK + 6 * PT_SEG + (g_) * PT_TILE + (tid >> 4) * 128 + (tid & 15) * 8; const bf16_t* wp_ = F_SGUW + (size_t)(g_) * 16384 + tid * 8; \
        _Pragma("unroll") for (int i_ = 0; i_ < 4; ++i_) { rvp[i_] = *(const u32x4*)(vp_ + (size_t)(i_ >> 1) * PT_CHUNK + (i_ & 1) * 32 * 128); rw[i_] = *(const u32x4*)(wp_ + i_ * 4096); } \
        lgn = F_ln_g[(g_) * 128 + d_e]; lbn = F_ln_b[(g_) * 128 + d_e]; bsn = F_sgu_b[(g_) * 128 + 16 * w + fr]; \
        const bf16_t* up_ = F_PROJ + (size_t)(((r0_) >> 6) + (w >> 2)) * PT_CHUNK + 5 * PT_SEG + (g_) * PT_TILE + (16 * (w & 3) + fr) * 128 + 8 * fq; \
        _Pragma("unroll") for (int i_ = 0; i_ < 4; ++i_) uwn[i_] = *(const u32x4*)(up_ + 32 * i_); } while (0)
    for (int item = F.bid; item < M / 128; item += F.G) {
        const size_t r0 = (size_t)item * 128;
        SGU_LOAD(r0, 0);
        if (tid < 128) { const float mu = vsum[r0 + tid] * (1.0f / 1024.0f); const float var = vssq[r0 + tid] * (1.0f / 1024.0f) - mu * mu; STAT[tid] = (f32x2){mu, __builtin_amdgcn_rsqf(fmaxf(var, 0.f) + EPS)}; }
        const int t = 16 * w + fr;
        float ssq = 0.f;
#pragma unroll 1
        for (int g = 0; g < 8; ++g) {
            const int wl = G_WL + (g & 1) * 128 * P128;
            const float lg = lgn, lb = lbn, bs = bsn; u32x4 uw[4];
#pragma unroll
            for (int i = 0; i < 4; ++i) uw[i] = uwn[i];
#pragma unroll
            for (int i = 0; i < 4; ++i) { const int p = tid + 512 * i, r = p >> 4, cc = p & 15;
                *(LAS u32x4*)(lds + G_RAW + r * 256 + cc * 16) = rvp[i]; *(LAS u32x4*)(lds + wl + r * P128 + cc * 16) = rw[i]; }
            if (g < 7) SGU_LOAD(r0, g + 1);
            LBAR();
            {
#pragma unroll
                for (int i = 0; i < 4; ++i) { float y[8];
#pragma unroll
                    for (int j = 0; j < 8; ++j) { const int s_ = 32 * sq + 8 * i + j; const f32x2 st = STAT[s_]; y[j] = (bf2f(lds_u16(lds + G_RAW + s_ * 256 + d_e * 2)) - st[0]) * st[1] * lg + lb; }
                    *(LAS u32x4*)(lds + G_VT + dr * P128 + (32 * sq + 8 * i) * 2) = pack8(y); }
            }
            LBAR();
            bf16x8 a[4];
#pragma unroll
            for (int ks = 0; ks < 4; ++ks) a[ks] = ldfrag(lds + wl, P128, 16 * w + fr, ks * 64 + fq * 16);
            bf16_t* op = F_CAT + (r0 + t) * DM + 1024 + g * 128 + 8 * fq;
#pragma unroll
            for (int gg = 0; gg < 4; ++gg) {
                f32x4 acc0 = {0.f, 0.f, 0.f, 0.f}, acc1 = {0.f, 0.f, 0.f, 0.f};
#pragma unroll
                for (int ks = 0; ks < 4; ++ks) { acc0 = MFMA16(a[ks], ldfrag(lds + G_VT, P128, 32 * gg + fr, ks * 64 + fq * 16), acc0); acc1 = MFMA16(a[ks], ldfrag(lds + G_VT, P128, 32 * gg + 16 + fr, ks * 64 + fq * 16), acc1); }
                const u32x4 uq = uw[gg];
                const float v0 = bflo(uq.x) * (acc0[0] + bs), v1 = bfhi(uq.x) * (acc0[1] + bs), v2 = bflo(uq.y) * (acc0[2] + bs), v3 = bfhi(uq.y) * (acc0[3] + bs);
                const float v4 = bflo(uq.z) * (acc1[0] + bs), v5 = bfhi(uq.z) * (acc1[1] + bs), v6 = bflo(uq.w) * (acc1[2] + bs), v7 = bfhi(uq.w) * (acc1[3] + bs);
                ssq += (v0 * v0 + v1 * v1) + (v2 * v2 + v3 * v3) + (v4 * v4 + v5 * v5) + (v6 * v6 + v7 * v7);
                u32x4 o; o.x = cvt_pk_bf16(v0, v1); o.y = cvt_pk_bf16(v2, v3); o.z = cvt_pk_bf16(v4, v5); o.w = cvt_pk_bf16(v6, v7);
                *(u32x4*)(op + 32 * gg) = o;
            }
        }
        ssq += __shfl_xor(ssq, 16); ssq += __shfl_xor(ssq, 32);
        const float rs = __builtin_amdgcn_rsqf(ssq * (1.0f / 1024.0f) + EPS);
        asm volatile("s_waitcnt vmcnt(0)" ::: "memory");
#pragma unroll 1
        for (int gh = 0; gh < 2; ++gh) {
            bf16_t* op = F_CAT + (r0 + t) * DM + 1024 + gh * 512 + 8 * fq; const float* og = F_sgu_onorm + gh * 512 + 8 * fq;
            u32x4 vw[16];
#pragma unroll
            for (int q = 0; q < 16; ++q) vw[q] = *(const u32x4*)(op + 32 * q);
#pragma unroll
            for (int q = 0; q < 16; ++q) { const f32x4 o4 = *(const f32x4*)(og + 32 * q), o5 = *(const f32x4*)(og + 32 * q + 4);
                u32x4 o; o.x = cvt_pk_bf16(bflo(vw[q].x) * rs * o4[0], bfhi(vw[q].x) * rs * o4[1]); o.y = cvt_pk_bf16(bflo(vw[q].y) * rs * o4[2], bfhi(vw[q].y) * rs * o4[3]);
                o.z = cvt_pk_bf16(bflo(vw[q].z) * rs * o5[0], bfhi(vw[q].z) * rs * o5[1]); o.w = cvt_pk_bf16(bflo(vw[q].w) * rs * o5[2], bfhi(vw[q].w) * rs * o5[3]);
                *(u32x4*)(op + 32 * q) = o; }
        }
        LBAR();
    }
#undef SGU_LOAD
}

__device__ __forceinline__ void final_norm(Frame& F) {
    PHASE_IDS();
    const int gw = F.bid * 8 + wave, NGW = F.G * 8;
    const float* ssq = F_ctl + CT_SSQ3;
    f32x4 gv[8];
#pragma unroll
    for (int j = 0; j < 8; ++j) gv[j] = *((const f32x4*)F_final_g + lane + 64 * j);
    for (int m = gw; m < M; m += 2 * NGW) {
        const int m2 = (m + NGW < M) ? m + NGW : m;
        const float rs = __builtin_amdgcn_rsqf(ssq[m] * (1.0f / DM) + EPS), rs2 = __builtin_amdgcn_rsqf(ssq[m2] * (1.0f / DM) + EPS);
        const u32x2* hr = (const u32x2*)(F_H3B + (size_t)m * DM) + lane; const u32x2* hr2 = (const u32x2*)(F_H3B + (size_t)m2 * DM) + lane;
        f32x4* xr = (f32x4*)(F.out + (size_t)m * DM) + lane; f32x4* xr2 = (f32x4*)(F.out + (size_t)m2 * DM) + lane;
        u32x2 hv[8], hv2[8];
#pragma unroll
        for (int j = 0; j < 8; ++j) { hv[j] = hr[64 * j]; hv2[j] = hr2[64 * j]; }
#pragma unroll
        for (int j = 0; j < 8; ++j) { f32x4 v = {bflo(hv[j].x), bfhi(hv[j].x), bflo(hv[j].y), bfhi(hv[j].y)}; v = v * rs * gv[j]; xr[64 * j] = v;
            f32x4 v2 = {bflo(hv2[j].x), bfhi(hv2[j].x), bflo(hv2[j].y), bfhi(hv2[j].y)}; v2 = v2 * rs2 * gv[j]; xr2[64 * j] = v2; }
    }
}

#define XB_TMO      128
#define XB_XCNT(j)  (256  + 64 * (j))
#define XB_XSUB(j)  (1280 + 64 * (j))
#define XB_XGEN(j)  (2304 + 64 * (j))
#define XB_TOP      3328
#define XB_TOPGEN   3392
#define XCD_BAR_WORDS 3456
#define XB_SPIN_CAP (1u << 18)

__device__ __forceinline__ unsigned xb_ld(unsigned* p)              { return __hip_atomic_load(p, __ATOMIC_RELAXED, __HIP_MEMORY_SCOPE_AGENT); }
__device__ __forceinline__ unsigned xb_add(unsigned* p, unsigned v) { return __hip_atomic_fetch_add(p, v, __ATOMIC_RELAXED, __HIP_MEMORY_SCOPE_AGENT); }
__device__ __forceinline__ unsigned xb_xcc_id() { return (unsigned)__builtin_amdgcn_s_getreg((3 << 11) | 20) & 0xFu; }
#define XB_SPIN(cond, bar) do { unsigned _sp = 0; while (cond) { __builtin_amdgcn_s_sleep(1); \
    if ((++_sp & 255u) == 0u) { if (xb_ld(&(bar)[XB_TMO])) break; if (_sp > XB_SPIN_CAP) { atomicAdd(&(bar)[XB_TMO], 1u); break; } } } } while (0)

struct XcdBarrier {
    unsigned* bar; unsigned x;
    volatile LAS unsigned* st;
};

__device__ __forceinline__ XcdBarrier xcd_barrier_post(unsigned* bar, volatile LAS unsigned* st) {
    XcdBarrier b; b.bar = bar; b.x = xb_xcc_id(); b.st = st;
    if (threadIdx.x == 0) (void)xb_add(&bar[XB_XCNT(b.x)], 1u);
    return b;
}
__device__ __forceinline__ void xcd_barrier_complete(unsigned* bar, unsigned x, unsigned& nloc, unsigned& nx) {
    const unsigned G = gridDim.x * gridDim.y * gridDim.z;
    unsigned sum, cnt, mine, sp = 0u;
    for (;;) {
        sum = 0u; cnt = 0u; mine = 0u;
#pragma unroll
        for (unsigned j = 0; j < 16; ++j) { const unsigned c = xb_ld(&bar[XB_XCNT(j)]); sum += c; cnt += (c > 0u) ? 1u : 0u; mine = (j == x) ? c : mine; }
        if (sum == G) break;
        __builtin_amdgcn_s_sleep(1);
        if ((++sp & 255u) == 0u) { if (xb_ld(&bar[XB_TMO])) break; if (sp > XB_SPIN_CAP) { atomicAdd(&bar[XB_TMO], 1u); break; } }
    }
    nloc = mine > 0u ? mine : 1u; nx = cnt > 0u ? cnt : 1u;
}

__device__ __forceinline__ void xcd_barrier(const XcdBarrier& b) {
    asm volatile("s_waitcnt vmcnt(0)" ::: "memory");
    __syncthreads();
    if (threadIdx.x == 0) {
        unsigned* bar = b.bar;
        __builtin_amdgcn_s_waitcnt(0);
        unsigned nloc = b.st[0], nx = b.st[1];
        if (nloc == 0u) { xcd_barrier_complete(bar, b.x, nloc, nx); b.st[0] = nloc; b.st[1] = nx; }
        const unsigned old = xb_add(&bar[XB_XSUB(b.x)], 1u);
        const unsigned gen = old / nloc;
        if (old + 1u == (gen + 1u) * nloc) {
            __builtin_amdgcn_fence(__ATOMIC_RELEASE, "agent");
            asm volatile("s_waitcnt vmcnt(0)" ::: "memory");
            const unsigned og = xb_add(&bar[XB_TOP], 1u);
            const unsigned tg = og / nx;
            if (og + 1u == (tg + 1u) * nx) xb_add(&bar[XB_TOPGEN], 1u);
            else XB_SPIN(xb_ld(&bar[XB_TOPGEN]) == tg, bar);
            __builtin_amdgcn_fence(__ATOMIC_ACQUIRE, "agent");
            xb_add(&bar[XB_XGEN(b.x)], 1u);
            asm volatile("s_waitcnt vmcnt(0)" ::: "memory");
        } else {
            XB_SPIN(xb_ld(&bar[XB_XGEN(b.x)]) == gen, bar);
            __builtin_amdgcn_fence(__ATOMIC_ACQUIRE, "agent");
            asm volatile("s_waitcnt vmcnt(0)" ::: "memory");
        }
    }
    __syncthreads();
}


constexpr int N_PHASES = 10;
__global__ void __launch_bounds__(512) mk_fwd(Args args) {
    extern __shared__ __attribute__((aligned(16))) unsigned char lds_raw[];
    Frame F;
    F.lds = (LAS unsigned char*)lds_raw;
    F.G = gridDim.x; F.bid = blockIdx.x;
    F.in = args.in; F.out = args.out; F.ws = args.ws;
    cg::grid_group grid = cg::this_grid();
    volatile LAS unsigned* bst = (volatile LAS unsigned*)(F.lds + LDS_BARST);
    if (threadIdx.x < 2) bst[threadIdx.x] = 0u;
    __syncthreads();
    const XcdBarrier bar = xcd_barrier_post((unsigned*)(args.ws + WS_BAR), bst);
    const int lo = args.ph_lo, hi = args.ph_hi;
#define IN(k) (lo <= (k) && (k) < hi)
#define SEAM(k) do { if (IN(k) && IN((k) + 1)) xcd_barrier(bar); } while (0)
    if (lo < 0) grid.sync();

    if (IN(0)) { p0_prologue(F); }
    SEAM(0);
    if (IN(1)) {
        { pg8::Gemm g{F_WIN, F_HB, 4096, M, DM}; pg8::StaticOrder S; S.init(4096, M, F.G, F.bid);
          EpiInT E{F_PROJ, F_ctl + CT_LBF, F_ctl + CT_LBB};
          pg8::gemm_phase<EpiInT, pg8::StaticOrder>(F.lds, g, S, E); }
        { pg8::Gemm g{F_HB, F_WIN + (size_t)4096 * DM, M, INC - 4096, DM}; pg8::StaticOrder S; S.init(M, INC - 4096, F.G, F.bid);
          EpiIn E{F_PROJ, F_ctl + CT_LBF, F_ctl + CT_LBB, F_ctl + CT_VSUM, F_ctl + CT_VSSQ, 4};
          pg8::gemm_phase<EpiIn, pg8::StaticOrder>(F.lds, g, S, E); }
    }
    SEAM(1);
    if (IN(2)) { hgrn_s1(F); __syncthreads(); sgu_phase(F); }
    SEAM(2);
    if (IN(3)) { hgrn_s2(F); }
    SEAM(3);
    if (IN(4)) { hgrn_s3(F); }
    SEAM(4);
    if (IN(5)) {
        pg8::Gemm g{F_CAT, F_WOUT, M, DM, DM}; pg8::StaticOrder S; S.init(M, DM, F.G, F.bid);
        EpiRes<false> E{F_x, F_HB, F_ctl + CT_SSQ1};
        pg8::gemm_phase<EpiRes<false>, pg8::StaticOrder>(F.lds, g, S, E);
    }
    SEAM(5);
    if (IN(6)) {
        { pg8::Gemm g{F_HB, F_WGU, M, 2 * FF, DM}; pg8::StaticOrder S; S.init(M, 2 * FF, F.G, F.bid);
          EpiGU E{F_ACT, F_ctl + CT_SSQ1};
          pg8::gemm_phase<EpiGU, pg8::StaticOrder>(F.lds, g, S, E); }
        { pg8::Gemm g{F_PBF, F_WPP, M, DM, PLE}; pg8::StaticOrder S; S.init(M, DM, F.G, F.bid);
          EpiPP E{F_PP};
          pg8::gemm_phase<EpiPP, pg8::StaticOrder>(F.lds, g, S, E); }
    }
    SEAM(6);
    if (IN(7)) {
        pg8::Gemm g{F_ACT, F_WDN, M, DM, FF}; pg8::StaticOrder S; S.init(M, DM, F.G, F.bid);
        EpiRes<true> E{nullptr, F_HB, F_ctl + CT_SSQ2};
        pg8::gemm_phase<EpiRes<true>, pg8::StaticOrder>(F.lds, g, S, E);
    }
    SEAM(7);
    if (IN(8)) {
        pg8::Gemm g{F_HB, F_WPG, M, DM, DM}; pg8::StaticOrder S; S.init(M, DM, F.G, F.bid);
        EpiPle E{F_HB, F_H3B, F_PP, F_ctl + CT_SSQ2, F_ctl + CT_SSQ3};
        pg8::gemm_phase<EpiPle, pg8::StaticOrder>(F.lds, g, S, E);
    }
    SEAM(8);
    if (IN(9)) { final_norm(F); }
#undef IN
#undef SEAM
}

extern "C" void kernel_launch(void* const* d_in, const int* in_sizes, int n_in, void* d_out, int out_size, void* d_ws, size_t ws_size, hipStream_t stream) {
    static int grid = 0;
    if (grid == 0) {
        if (n_in != 21 || out_size != M * DM || ws_size < WS_END) { fprintf(stderr, "kernel_launch: unexpected sizes n_in %d out %d ws %zu\n", n_in, out_size, ws_size); grid = -1; return; }
        int dev = 0, cus = 0, per_cu = 0;
        hipGetDevice(&dev); hipDeviceGetAttribute(&cus, hipDeviceAttributeMultiprocessorCount, dev);
        if (hipFuncSetAttribute((const void*)mk_fwd, hipFuncAttributeMaxDynamicSharedMemorySize, LDS_BYTES) != hipSuccess) { fprintf(stderr, "kernel_launch: hipFuncSetAttribute failed\n"); grid = -1; return; }
        if (hipOccupancyMaxActiveBlocksPerMultiprocessor(&per_cu, (const void*)mk_fwd, 512, LDS_BYTES) != hipSuccess || per_cu < 1) { fprintf(stderr, "kernel_launch: occupancy query gave %d\n", per_cu); per_cu = 1; }
        (void)hipGetLastError();
        grid = cus * 1;
        fprintf(stderr, "kernel_launch: cus %d per_cu %d grid %d\n", cus, per_cu, grid);
    }
    if (grid < 0) return;
    if (hipMemsetAsync((char*)d_ws + WS_BAR, 0, XCD_BAR_WORDS * 4, stream) != hipSuccess) { fprintf(stderr, "kernel_launch: memset of barrier words failed\n"); return; }
    Args a{};
    for (int i = 0; i < 21; ++i) a.in[i] = (const float*)d_in[i];
    a.out = (float*)d_out; a.ws = (unsigned char*)d_ws;
#if MK_N_LAUNCHES == 1
    a.ph_lo = 0; a.ph_hi = N_PHASES;
    void* kargs[] = {&a};
    hipError_t e = hipLaunchCooperativeKernel((const void*)mk_fwd, dim3(grid), dim3(512), kargs, LDS_BYTES, stream);
    if (e != hipSuccess) fprintf(stderr, "kernel_launch: cooperative launch failed: %s (grid %d)\n", hipGetErrorString(e), grid);
#else
    for (int ph = 0; ph < N_PHASES; ++ph) {
        a.ph_lo = ph; a.ph_hi = ph + 1;
        void* kargs[] = {&a};
        hipError_t e = hipLaunchCooperativeKernel((const void*)mk_fwd, dim3(grid), dim3(512), kargs, LDS_BYTES, stream);
        if (e != hipSuccess) { fprintf(stderr, "kernel_launch: launch %d failed: %s (grid %d)\n", ph, hipGetErrorString(e), grid); break; }
    }
#endif
}
```
